# Optimizing an MI355X kernel written in HIP

```python
import math
import jax, jax.numpy as jnp
from jax import lax
import numpy as np

D_MODEL = 2048
BATCH = 2
SEQ = 4096
DEPTH = 1
DEC_BATCH = 8
DEC_SEQ = 8
PAST_LEN = 16384
PAGE_SIZE = 128

D_MIX = D_MODEL
W_A = D_MIX // 2
W_B = D_MIX - W_A
HD_A = 128
H_A = W_A // HD_A
CHUNK = 128
H_B = 8
DV_B = W_B // H_B
DH_B = DV_B // 2
D_IN = 2 * W_A + 3 * W_B
D_FF = (11 * D_MODEL) // 4
CONV_W = 3
Q_BLOCK = 128
EPS = 1e-6
SPARE_NUM = 5
SPARE_DEN = 4

kernel_name = 'hymba_gmlp_diffattn_convffn_step'


def rmsnorm(x, g):
    xf = x.astype(jnp.float32)
    y = xf * lax.rsqrt(jnp.mean(xf * xf, axis=-1, keepdims=True) + EPS)
    return (y * g.astype(jnp.float32)).astype(x.dtype)


def diff_lambda(lq1, lk1, lq2, lk2, lam_init):
    f = lambda a: a.astype(jnp.float32)
    return jnp.exp(jnp.sum(f(lq1) * f(lk1))) - jnp.exp(jnp.sum(f(lq2) * f(lk2))) + lam_init


def diff_attend(q, k, v, q_pos, k_pos, lam):
    scale = DH_B ** -0.5
    mask = k_pos[None, :] <= q_pos[:, None]

    def probs(qh, kh):
        s = jnp.einsum('bqhd,bkhd->bhqk', qh, kh).astype(jnp.float32) * scale
        return jax.nn.softmax(jnp.where(mask, s, -jnp.inf), axis=-1)

    w = probs(q[..., :DH_B], k[..., :DH_B]) - lam * probs(q[..., DH_B:], k[..., DH_B:])
    return jnp.einsum('bhqk,bkhe->bqhe', w.astype(v.dtype), v)


def prompt_attend(q, k, v, lam):
    B, S = q.shape[:2]
    nb = S // Q_BLOCK
    qb = q.reshape(B, nb, Q_BLOCK, H_B, DV_B).transpose(1, 0, 2, 3, 4)
    k_pos = jnp.arange(S)

    def block(args):
        qi, start = args
        return diff_attend(qi, k, v, start + jnp.arange(Q_BLOCK), k_pos, lam)

    o = lax.map(block, (qb, jnp.arange(nb) * Q_BLOCK))
    return o.transpose(1, 0, 2, 3, 4).reshape(B, S, H_B, DV_B)


def sample_attend(q, k_new, v_new, k_cache, v_cache, page_table, lam):
    DB, T = q.shape[:2]
    past = page_table.shape[1] * PAGE_SIZE
    k_past = k_cache[page_table].reshape(DB, past, H_B, DV_B)
    v_past = v_cache[page_table].reshape(DB, past, H_B, DV_B)
    k = jnp.concatenate([k_past, k_new.astype(k_past.dtype)], axis=1)
    v = jnp.concatenate([v_past, v_new.astype(v_past.dtype)], axis=1)
    return diff_attend(q, k, v, past + jnp.arange(T), jnp.arange(past + T), lam)


def chunk_gmlp(u, va, w_s, b_s):
    B, T = va.shape[:2]
    pad = (-T) % CHUNK
    nc = (T + pad) // CHUNK
    vc = jnp.pad(va, ((0, 0), (0, pad), (0, 0), (0, 0))).reshape(B, nc, CHUNK, H_A, HD_A)
    w = w_s * jnp.tril(jnp.ones((CHUNK, CHUNK), w_s.dtype))
    mixed = jnp.einsum('hts,bcshd->bcthd', w, vc) + b_s.T[:, :, None]
    mixed = mixed.reshape(B, nc * CHUNK, H_A, HD_A)[:, :T]
    return (u.reshape(B, T, H_A, HD_A) * mixed).reshape(B, T, W_A)


def causal_dwconv(hist, up, w_conv, b_conv):
    T = up.shape[1]
    hp = jnp.concatenate([hist.astype(up.dtype), up], axis=1)
    out = b_conv + sum(hp[:, j:j + T] * w_conv[j] for j in range(CONV_W))
    return out, hp[:, T:]


def layer(x, conv_hist, attend, lp, lam, lam_init):
    B, T, _ = x.shape
    z = rmsnorm(x, lp['g_pre_mix']) @ lp['w_in']
    u, va, q, k, vb = jnp.split(z, [W_A, 2 * W_A, 2 * W_A + W_B, 2 * W_A + 2 * W_B], axis=-1)
    u = jax.nn.gelu(u)
    va = rmsnorm(jax.nn.gelu(va).reshape(B, T, H_A, HD_A), lp['g_v_a'])
    q = q.reshape(B, T, H_B, DV_B)
    k = k.reshape(B, T, H_B, DV_B)
    vb = vb.reshape(B, T, H_B, DV_B)
    a_out = chunk_gmlp(u, va, lp['w_s'], lp['b_s'])
    o = attend(q, k, vb, lam)
    b_out = (rmsnorm(o, lp['g_subln']) * (1.0 - lam_init)).reshape(B, T, W_B)
    mix = jnp.concatenate([a_out, b_out.astype(a_out.dtype)], axis=-1) @ lp['w_out']
    h = x + rmsnorm(mix, lp['g_post_mix'])
    up = rmsnorm(h, lp['g_pre_ffn']) @ lp['w_up']
    c, new_hist = causal_dwconv(conv_hist, up, lp['w_conv'], lp['b_conv'])
    gate, val = jnp.split(c, 2, axis=-1)
    y = (jax.nn.gelu(gate) * val) @ lp['w_down']
    return h + rmsnorm(y, lp['g_post_ffn']), k, vb, new_hist, va


def setup_inputs(seed: int = 0) -> dict:
    key = jax.random.key(seed)
    ks = jax.random.split(key, 26)
    n_pages = PAST_LEN // PAGE_SIZE
    n_phys = (DEC_BATCH * n_pages * SPARE_NUM) // SPARE_DEN
    f32 = jnp.float32
    nrm = lambda k, shape, s: jax.random.normal(k, shape, f32) * s
    gain = lambda k, n: 1.0 + 0.05 * jax.random.normal(k, (DEPTH, n), f32)
    perm = jax.random.permutation(ks[5], n_phys)[:DEC_BATCH * n_pages]
    return {
        'x_prompt': nrm(ks[0], (BATCH, SEQ, D_MODEL), 1.0),
        'x_sample': nrm(ks[1], (DEC_BATCH, DEC_SEQ, D_MODEL), 1.0),
        'cache_k': nrm(ks[2], (DEPTH, n_phys, PAGE_SIZE, H_B, DV_B), 1.0),
        'cache_v': nrm(ks[3], (DEPTH, n_phys, PAGE_SIZE, H_B, DV_B), 1.0),
        'state_conv': nrm(ks[4], (DEPTH, DEC_BATCH, CONV_W - 1, 2 * D_FF), 1.0),
        'page_table': perm.reshape(DEC_BATCH, n_pages).astype(jnp.int32),
        'g_pre_mix': gain(ks[6], D_MODEL),
        'w_in': nrm(ks[7], (DEPTH, D_MODEL, D_IN), D_MODEL ** -0.5),
        'g_v_a': 1.0 + 0.05 * jax.random.normal(ks[8], (DEPTH, H_A, HD_A), f32),
        'w_s': nrm(ks[9], (DEPTH, H_A, CHUNK, CHUNK), CHUNK ** -0.5),
        'b_s': 1.0 + 0.1 * jax.random.normal(ks[10], (DEPTH, H_A, CHUNK), f32),
        'lam_q1': nrm(ks[11], (DEPTH, DH_B), 0.1),
        'lam_k1': nrm(ks[12], (DEPTH, DH_B), 0.1),
        'lam_q2': nrm(ks[13], (DEPTH, DH_B), 0.1),
        'lam_k2': nrm(ks[14], (DEPTH, DH_B), 0.1),
        'g_subln': gain(ks[15], DV_B),
        'w_out': nrm(ks[16], (DEPTH, D_MIX, D_MODEL), D_MIX ** -0.5),
        'g_post_mix': gain(ks[17], D_MODEL),
        'g_pre_ffn': gain(ks[18], D_MODEL),
        'w_up': nrm(ks[19], (DEPTH, D_MODEL, 2 * D_FF), D_MODEL ** -0.5),
        'w_conv': nrm(ks[20], (DEPTH, CONV_W, 2 * D_FF), CONV_W ** -0.5),
        'b_conv': nrm(ks[21], (DEPTH, 2 * D_FF), 0.02),
        'w_down': nrm(ks[22], (DEPTH, D_FF, D_MODEL), D_FF ** -0.5),
        'g_post_ffn': gain(ks[23], D_MODEL),
    }


def reference(x_prompt, x_sample, cache_k, cache_v, state_conv, page_table,
              g_pre_mix, w_in, g_v_a, w_s, b_s, lam_q1, lam_k1, lam_q2, lam_k2,
              g_subln, w_out, g_post_mix, g_pre_ffn, w_up, w_conv, b_conv, w_down,
              g_post_ffn):
    xp, xs = x_prompt, x_sample
    kp_l, vp_l, cp_l, ks_l, vs_l, cs_l, gs_l = [], [], [], [], [], [], []
    for l in range(DEPTH):
        lp = {'g_pre_mix': g_pre_mix[l], 'w_in': w_in[l], 'g_v_a': g_v_a[l],
              'w_s': w_s[l], 'b_s': b_s[l], 'g_subln': g_subln[l], 'w_out': w_out[l],
              'g_post_mix': g_post_mix[l], 'g_pre_ffn': g_pre_ffn[l], 'w_up': w_up[l],
              'w_conv': w_conv[l], 'b_conv': b_conv[l], 'w_down': w_down[l],
              'g_post_ffn': g_post_ffn[l]}
        lam_init = 0.8 - 0.6 * math.exp(-0.3 * l)
        lam = diff_lambda(lam_q1[l], lam_k1[l], lam_q2[l], lam_k2[l], lam_init)
        hist0 = jnp.zeros((xp.shape[0], CONV_W - 1, 2 * D_FF), xp.dtype)
        xp, kp, vp, cp, _ = layer(xp, hist0, prompt_attend, lp, lam, lam_init)
        kc, vc = cache_k[l], cache_v[l]
        attend_s = lambda q, k, v, lm, kc=kc, vc=vc: sample_attend(q, k, v, kc, vc, page_table, lm)
        xs, ksn, vsn, csn, gsn = layer(xs, state_conv[l], attend_s, lp, lam, lam_init)
        kp_l.append(kp); vp_l.append(vp); cp_l.append(cp)
        ks_l.append(ksn); vs_l.append(vsn); cs_l.append(csn); gs_l.append(gsn)
    k_prompt = jnp.stack(kp_l, 0)
    v_prompt = jnp.stack(vp_l, 0)
    conv_prompt = jnp.stack(cp_l, 0)
    k_sample = jnp.stack(ks_l, 0)
    v_sample = jnp.stack(vs_l, 0)
    conv_sample = jnp.stack(cs_l, 0)
    gmlp_v_sample = jnp.stack(gs_l, 0)
    return (xp, xs, k_prompt, v_prompt, conv_prompt, k_sample, v_sample, conv_sample, gmlp_v_sample)
```

```cpp
#define MK_N_LAUNCHES 1
#include <hip/hip_runtime.h>
#include <cstdio>
#include <cstdint>
namespace pg8 {
#define PG8_LAS __attribute__((address_space(3)))
typedef unsigned short bf16_t;
typedef short bf16x8 __attribute__((ext_vector_type(8)));
typedef float f32x4 __attribute__((ext_vector_type(4)));
typedef unsigned u32x4 __attribute__((ext_vector_type(4)));
constexpr int BM = 256, BK = 64, HALF = 128, HTB = HALF * BK * 2  , STAGE_BYTES = 8 * HTB, NXCD = 8, WGM = 8;

__host__ __device__ __forceinline__ int lds_byte(int r, int c) { const int st = (r >> 4) * 2 + (c >> 5), rr = r & 15, cc = c & 31, ob = rr * 64 + cc * 2; return st * 1024 + (ob ^ (((ob >> 9) & 1) << 5)); }
__host__ __device__ __forceinline__ void stage_rc(int b, int& R, int& C) { const int st = b / 1024, sb = b % 1024, swz = sb ^ (((sb >> 9) & 1) << 5); R = (st >> 1) * 16 + swz / 64; C = (st & 1) * 32 + (swz % 64) / 2; }
__host__ __device__ __forceinline__ int perm32(int rho) { const int n = rho >> 4, i = rho & 15; return 8 * (i >> 2) + 4 * n + (i & 3); }

struct Unit { int pm, pn; };
struct Gemm { const bf16_t* A; const bf16_t* Bt; int M, N, K; };

struct StaticOrder {
    int nM, nN, nwg, G, c;
    __host__ __device__ void init(int M, int N, int G_, int c_) { nM = M / BM; nN = N / BM; nwg = nM * nN; G = G_; c = c_; }
    __host__ __device__ bool next(int i, Unit& u) const {
        const long L = (long)i * G + c; if (L >= nwg) return false;
        int wgid = (int)L; { const int q = nwg / NXCD, r = nwg % NXCD, xcd = wgid % NXCD, off = wgid / NXCD; wgid = (xcd < r ? xcd * (q + 1) : r * (q + 1) + (xcd - r) * q) + off; }
        const int nig = WGM * nN, gid = wgid / nig, fm = gid * WGM, gsz = (nM - fm) < WGM ? (nM - fm) : WGM;
        u.pm = fm + ((wgid % nig) % gsz); u.pn = (wgid % nig) / gsz; return true;
    }
    __device__ __forceinline__ void a_ready(const Unit&) const {}
    __device__ __forceinline__ void done(const Unit&) const {}
};

__device__ __forceinline__ unsigned cvt_pk_bf16(float lo, float hi) { unsigned r; asm volatile("v_cvt_pk_bf16_f32 %0, %1, %2" : "=v"(r) : "v"(lo), "v"(hi)); return r; }
__device__ __forceinline__ float gelu_t(float x) {
    const float z = x * (1.0f + 0.044715f * x * x) * (-2.3022081985f);
    return x * __builtin_amdgcn_rcpf(1.0f + __builtin_amdgcn_exp2f(z));
}
__device__ __forceinline__ f32x4 gelu4(f32x4 v) { return (f32x4){gelu_t(v[0]), gelu_t(v[1]), gelu_t(v[2]), gelu_t(v[3])}; }
__device__ __forceinline__ u32x4 pack8(f32x4 v0, f32x4 v1) { u32x4 w; w.x = cvt_pk_bf16(v0[0], v0[1]); w.y = cvt_pk_bf16(v0[2], v0[3]); w.z = cvt_pk_bf16(v1[0], v1[1]); w.w = cvt_pk_bf16(v1[2], v1[3]); return w; }

constexpr int E_MP = 8192, E_MS = 64;

struct EpiIn {
    static constexpr bool PERM = true, AFTER_DRAIN = false;
    bf16_t *U, *VA, *Q, *K, *V; float *kp, *vp, *ks, *vs; float qscale;
    __device__ __forceinline__ void operator()(const f32x4 (&acc)[2][2][4][2], const Unit& u, int wr, int wc, int fr, int fq) const {
        const int t = u.pn >> 2;
        const int row0 = u.pm * BM + wr * 64 + fr, col0 = (u.pn & 3) * BM + wc * 32 + 8 * fq;
        bf16_t* base = t == 0 ? U : t == 1 ? VA : t == 2 ? Q : t == 3 ? K : V;
        float* fp = t == 3 ? kp : vp; float* fs = t == 3 ? ks : vs;
#pragma unroll
        for (int ai = 0; ai < 2; ++ai)
#pragma unroll
            for (int m = 0; m < 4; ++m) { const int row = row0 + ai * HALF + m * 16; bf16_t* rowp = base + (size_t)row * 1024 + col0;
                float* fo = nullptr; if (t >= 3) { if (row < E_MP) fo = fp + (size_t)row * 1024 + col0; else if (row < E_MP + E_MS) fo = fs + (size_t)(row - E_MP) * 1024 + col0; }
#pragma unroll
                for (int bj = 0; bj < 2; ++bj) { f32x4 v0 = acc[ai][bj][m][0], v1 = acc[ai][bj][m][1];
                    if (t < 2) { v0 = gelu4(v0); v1 = gelu4(v1); } else if (t == 2) { v0 = v0 * qscale; v1 = v1 * qscale; }
                    *(u32x4*)(rowp + bj * HALF) = pack8(v0, v1);
                    if (fo) { *(f32x4*)(fo + bj * HALF) = v0; *(f32x4*)(fo + bj * HALF + 4) = v1; } } }
    }
};
struct EpiF32 {
    static constexpr bool PERM = true, AFTER_DRAIN = false;
    float* O; int ldc;
    __device__ __forceinline__ void operator()(const f32x4 (&acc)[2][2][4][2], const Unit& u, int wr, int wc, int fr, int fq) const {
        const int row0 = u.pm * BM + wr * 64 + fr, col0 = u.pn * BM + wc * 32 + 8 * fq;
#pragma unroll
        for (int ai = 0; ai < 2; ++ai)
#pragma unroll
            for (int m = 0; m < 4; ++m) { float* rowp = O + (size_t)(row0 + ai * HALF + m * 16) * ldc + col0;
#pragma unroll
                for (int bj = 0; bj < 2; ++bj) { *(f32x4*)(rowp + bj * HALF) = acc[ai][bj][m][0]; *(f32x4*)(rowp + bj * HALF + 4) = acc[ai][bj][m][1]; } }
    }
};
struct EpiUp {
    static constexpr bool PERM = true, AFTER_DRAIN = false;
    bf16_t* UP; float *cp, *cs;
    __device__ __forceinline__ void operator()(const f32x4 (&acc)[2][2][4][2], const Unit& u, int wr, int wc, int fr, int fq) const {
        const int row0 = u.pm * BM + wr * 64 + fr, col0 = u.pn * BM + wc * 32 + 8 * fq;
#pragma unroll
        for (int ai = 0; ai < 2; ++ai)
#pragma unroll
            for (int m = 0; m < 4; ++m) { const int row = row0 + ai * HALF + m * 16; bf16_t* rowp = UP + (size_t)row * 11264 + col0;
                float* fo = nullptr;
                if (row < E_MP) { const int t = row & 4095; if (t >= 4094) fo = cp + (size_t)((row >> 12) * 2 + (t - 4094)) * 11264 + col0; }
                else if (row < E_MP + E_MS) { const int t = row & 7; if (t >= 6) fo = cs + (size_t)(((row - E_MP) >> 3) * 2 + (t - 6)) * 11264 + col0; }
#pragma unroll
                for (int bj = 0; bj < 2; ++bj) { const f32x4 v0 = acc[ai][bj][m][0], v1 = acc[ai][bj][m][1];
                    *(u32x4*)(rowp + bj * HALF) = pack8(v0, v1);
                    if (fo) { *(f32x4*)(fo + bj * HALF) = v0; *(f32x4*)(fo + bj * HALF + 4) = v1; } } }
    }
};
template <class Epi, class Sched, bool ALIGN_EPI = false, bool SP2 = false>
__device__ __forceinline__ void gemm_phase(PG8_LAS unsigned char* lds, const Gemm g, const Sched& S, const Epi& E) {
    const int tid = threadIdx.x, wid = __builtin_amdgcn_readfirstlane(tid >> 6), lane = tid & 63, wr = wid >> 2, wc = wid & 3, fr = lane & 15, fq = lane >> 4;
    const int K = g.K, nt = K / BK;
    unsigned voffA[2], voffB[2];
#pragma unroll
    for (int i = 0; i < 2; ++i) { int R, C; stage_rc(tid * 16 + i * 8192, R, C); const int Rb = Epi::PERM ? ((R & ~31) + perm32(R & 31)) : R;
        voffA[i] = (unsigned)(R * K + C) * 2u; voffB[i] = (unsigned)(Rb * K + C) * 2u; }
    const size_t kstep = (size_t)(BK * 2);
    const size_t hstep = (size_t)HALF * K * 2;
    const size_t tstep = 2 * hstep;
    const unsigned ldsw = (unsigned)wid * 1024u;
    const int aoff = lds_byte(wr * 64 + fr, fq * 8), boff = lds_byte(wc * 32 + fr, fq * 8);
#define PG8_SA(b, h) (((b) * 2 + (h)) * HTB)
#define PG8_SB(b, h) ((4 + (b) * 2 + (h)) * HTB)
#define PG8_STAGE(bufoff, gbase, voff) do { _Pragma("unroll") for (int _i = 0; _i < 2; ++_i) \
        __builtin_amdgcn_global_load_lds((const unsigned*)((const char*)(gbase) + (voff)[_i]), (PG8_LAS unsigned*)(lds + (bufoff) + ldsw + _i * 8192), 16, 0, 0); } while (0)
#define PG8_LDA(dst, b, h) do { _Pragma("unroll") for (int m = 0; m < 4; ++m) _Pragma("unroll") for (int k = 0; k < 2; ++k) dst[m][k] = *(const PG8_LAS bf16x8*)(lds + PG8_SA(b, h) + aoff + m * 2048 + k * 1024); } while (0)
#define PG8_LDB(dst, b, h) do { _Pragma("unroll") for (int n = 0; n < 2; ++n) _Pragma("unroll") for (int k = 0; k < 2; ++k) dst[n][k] = *(const PG8_LAS bf16x8*)(lds + PG8_SB(b, h) + boff + n * 2048 + k * 1024); } while (0)
#define PG8_MMA(ai, bj, At, Bt) do { __builtin_amdgcn_s_setprio(1); _Pragma("unroll") for (int m = 0; m < 4; ++m) _Pragma("unroll") for (int n = 0; n < 2; ++n) _Pragma("unroll") for (int k = 0; k < 2; ++k) \
        acc[ai][bj][m][n] = __builtin_amdgcn_mfma_f32_16x16x32_bf16(Bt[n][k], At[m][k], acc[ai][bj][m][n], 0, 0, 0); __builtin_amdgcn_s_setprio(0); } while (0)
#define PG8_WAIT_V(n) asm volatile("s_waitcnt vmcnt(" #n ")" ::: "memory")
#define PG8_WAIT_L(n) asm volatile("s_waitcnt lgkmcnt(" #n ")" ::: "memory")
#define PG8_BAR __builtin_amdgcn_s_barrier()
#define PG8_SCHED __builtin_amdgcn_sched_barrier(0)
    Unit cur, nxt; int ui = 0;
    if (!S.next(0, cur)) return;
    f32x4 acc[2][2][4][2];
#pragma unroll
    for (int a = 0; a < 2; ++a)
#pragma unroll
        for (int b = 0; b < 2; ++b)
#pragma unroll
            for (int m = 0; m < 4; ++m)
#pragma unroll
                for (int n = 0; n < 2; ++n) acc[a][b][m][n] = (f32x4){0.f, 0.f, 0.f, 0.f};
    bf16x8 At[4][2], B0[2][2], B1[2][2];
    const char* cA = (const char*)g.A + (size_t)cur.pm * tstep; const char* cB = (const char*)g.Bt + (size_t)cur.pn * tstep;
    S.a_ready(cur);
    if constexpr (SP2) {
        PG8_STAGE(PG8_SB(0, 0), cB, voffB); PG8_STAGE(PG8_SB(0, 1), cB + hstep, voffB); PG8_STAGE(PG8_SA(0, 0), cA, voffA); PG8_STAGE(PG8_SA(0, 1), cA + hstep, voffA);
        if (wr == 1) PG8_BAR;
        PG8_WAIT_V(2); PG8_BAR;
        PG8_STAGE(PG8_SB(1, 0), cB + kstep, voffB); PG8_STAGE(PG8_SA(1, 0), cA + kstep, voffA); PG8_STAGE(PG8_SB(1, 1), cB + hstep + kstep, voffB);
        PG8_WAIT_V(6); PG8_BAR;
    } else {
        PG8_STAGE(PG8_SB(0, 0), cB, voffB); PG8_STAGE(PG8_SA(0, 0), cA, voffA); PG8_STAGE(PG8_SB(0, 1), cB + hstep, voffB); PG8_STAGE(PG8_SA(0, 1), cA + hstep, voffA);
        if (wr == 1) PG8_BAR;
        PG8_WAIT_V(4); PG8_BAR;
        PG8_STAGE(PG8_SB(1, 0), cB + kstep, voffB); PG8_STAGE(PG8_SA(1, 0), cA + kstep, voffA); PG8_STAGE(PG8_SB(1, 1), cB + hstep + kstep, voffB);
        PG8_WAIT_V(6); PG8_BAR;
    }
    for (;;) {
        const bool has_next = S.next(ui + 1, nxt);
        const char* nA = has_next ? (const char*)g.A + (size_t)nxt.pm * tstep : cA; const char* nB = has_next ? (const char*)g.Bt + (size_t)nxt.pn * tstep : cB;
        for (int t = 0; t < nt; t += 2) {
            const bool last = (t == nt - 2);
            const char* a1 = cA + (size_t)(t + 1) * kstep;
            const char* a2 = last ? nA : cA + (size_t)(t + 2) * kstep; const char* b2 = last ? nB : cB + (size_t)(t + 2) * kstep;
            const char* a3 = a2 + kstep; const char* b3 = b2 + kstep;
            if (last && has_next) S.a_ready(nxt);
            if constexpr (SP2) {
            PG8_LDB(B0, 0, 0); PG8_LDB(B1, 0, 1); PG8_SCHED; PG8_LDA(At, 0, 0); PG8_STAGE(PG8_SA(1, 1), a1 + hstep, voffA);
            PG8_WAIT_V(8); PG8_WAIT_L(0); PG8_BAR; PG8_MMA(0, 0, At, B0); PG8_MMA(0, 1, At, B1); PG8_BAR; PG8_SCHED;
            PG8_LDA(At, 0, 1); PG8_STAGE(PG8_SB(0, 0), b2, voffB); PG8_STAGE(PG8_SB(0, 1), b2 + hstep, voffB); PG8_STAGE(PG8_SA(0, 0), a2, voffA);
            PG8_WAIT_V(8); PG8_WAIT_L(0); PG8_BAR; PG8_MMA(1, 0, At, B0); PG8_MMA(1, 1, At, B1); PG8_BAR; PG8_SCHED;
            PG8_LDB(B0, 1, 0); PG8_LDB(B1, 1, 1); PG8_SCHED; PG8_LDA(At, 1, 0); PG8_STAGE(PG8_SA(0, 1), a2 + hstep, voffA);
            PG8_WAIT_V(8); PG8_WAIT_L(0); PG8_BAR; PG8_MMA(0, 0, At, B0); PG8_MMA(0, 1, At, B1); PG8_BAR; PG8_SCHED;
            PG8_LDA(At, 1, 1); PG8_STAGE(PG8_SB(1, 0), b3, voffB); PG8_STAGE(PG8_SB(1, 1), b3 + hstep, voffB); PG8_STAGE(PG8_SA(1, 0), a3, voffA);
            PG8_WAIT_V(8); PG8_WAIT_L(0); PG8_BAR; PG8_MMA(1, 0, At, B0); PG8_MMA(1, 1, At, B1); PG8_BAR; PG8_SCHED;
            } else {
            PG8_LDB(B0, 0, 0); PG8_SCHED; PG8_LDA(At, 0, 0); PG8_STAGE(PG8_SA(1, 1), a1 + hstep, voffA);
            PG8_WAIT_L(8); PG8_BAR; PG8_WAIT_L(0); PG8_MMA(0, 0, At, B0); PG8_BAR; PG8_SCHED;
            PG8_LDB(B1, 0, 1); PG8_STAGE(PG8_SB(0, 0), b2, voffB);
            PG8_BAR; PG8_WAIT_L(0); PG8_MMA(0, 1, At, B1); PG8_BAR;
            PG8_LDA(At, 0, 1); PG8_STAGE(PG8_SA(0, 0), a2, voffA);
            PG8_BAR; PG8_WAIT_L(0); PG8_MMA(1, 0, At, B0); PG8_BAR; PG8_SCHED;
            PG8_STAGE(PG8_SB(0, 1), b2 + hstep, voffB);
            PG8_WAIT_V(6); PG8_BAR; PG8_MMA(1, 1, At, B1); PG8_BAR;
            PG8_LDB(B0, 1, 0); PG8_SCHED; PG8_LDA(At, 1, 0); PG8_STAGE(PG8_SA(0, 1), a2 + hstep, voffA);
            PG8_WAIT_L(8); PG8_BAR; PG8_WAIT_L(0); PG8_MMA(0, 0, At, B0); PG8_BAR; PG8_SCHED;
            PG8_LDB(B1, 1, 1); PG8_STAGE(PG8_SB(1, 0), b3, voffB);
            PG8_BAR; PG8_WAIT_L(0); PG8_MMA(0, 1, At, B1); PG8_BAR;
            PG8_LDA(At, 1, 1); PG8_STAGE(PG8_SA(1, 0), a3, voffA);
            PG8_BAR; PG8_WAIT_L(0); PG8_MMA(1, 0, At, B0); PG8_BAR; PG8_SCHED;
            PG8_STAGE(PG8_SB(1, 1), b3 + hstep, voffB);
            PG8_WAIT_V(6); PG8_BAR; PG8_MMA(1, 1, At, B1); PG8_BAR;
            }
        }
        if constexpr (ALIGN_EPI) { if (wr == 0) PG8_BAR; }
        if constexpr (!Epi::AFTER_DRAIN) { E(acc, cur, wr, wc, fr, fq); S.done(cur); }
        if (!has_next) break;
#pragma unroll
        for (int a = 0; a < 2; ++a)
#pragma unroll
            for (int b = 0; b < 2; ++b)
#pragma unroll
                for (int m = 0; m < 4; ++m)
#pragma unroll
                    for (int n = 0; n < 2; ++n) acc[a][b][m][n] = (f32x4){0.f, 0.f, 0.f, 0.f};
        cur = nxt; cA = nA; cB = nB; ++ui;
        if constexpr (ALIGN_EPI) { if (wr == 1) PG8_BAR; }
    }
    PG8_WAIT_V(0);
    if constexpr (!ALIGN_EPI) { if (wr == 0) PG8_BAR; }
    PG8_BAR;
    if constexpr (Epi::AFTER_DRAIN) { E.fused(acc, cur, wr, wc, fr, fq, lds, wid, lane); S.done(cur); }
#undef PG8_SA
#undef PG8_SB
#undef PG8_STAGE
#undef PG8_LDA
#undef PG8_LDB
#undef PG8_MMA
#undef PG8_WAIT_V
#undef PG8_WAIT_L
#undef PG8_BAR
#undef PG8_SCHED
}
}

#ifndef PG8_SP2
#define PG8_SP2 true
#endif
#ifndef PG8_ALIGN
#define PG8_ALIGN true
#endif
#include <hip/hip_bf16.h>
#include <cmath>
namespace attn_body {
using bf16=__hip_bfloat16;
using bf16x8=__attribute__((ext_vector_type(8)))short;
using s16x4=__attribute__((ext_vector_type(4)))short;
using f32x16=__attribute__((ext_vector_type(16)))float;
using u32x4=__attribute__((ext_vector_type(4)))unsigned;
constexpr int BATCH=2,NHEAD=16,SEQ=4096,D=64,DM=NHEAD*D,OP=2048;
constexpr int NW=8,QBLK=32,QB=QBLK*NW,KVBLK=64,NQB=SEQ/QB;
constexpr int ATTN_PITCH=DM, ATTN_UNIT_ROWS=QB;
__device__ __forceinline__ int crow(int r,int hi){return (r&3)+8*(r>>2)+4*hi;}
#define SBAR() __builtin_amdgcn_sched_barrier(0)
__device__ __forceinline__ void cmask(f32x16&p0,f32x16&p1,int jb,int qrel,int hi){
  const float NEG=-INFINITY; int kb=64*jb+4*hi;
  #pragma unroll
  for(int r=0;r<16;++r){int kv=kb+(r&3)+8*(r>>2); if(kv>qrel)p0[r]=NEG; if(kv+32>qrel)p1[r]=NEG;}
}

constexpr int NSLOT=3, SLOTB=8192;
constexpr int LDS_K=0, LDS_V=NSLOT*SLOTB, LDS_WS=2*NSLOT*SLOTB, LDS_OST=LDS_WS+NW*64*4, LDS_BYTES=LDS_OST+NW*4096;
constexpr float C2=0.125f*1.4426950408889634f;
__device__ __forceinline__ void glds16(const void*gsrc,unsigned lds_dst){unsigned keep;
  asm volatile("s_mov_b32 %0, m0\n\ts_mov_b32 m0, %2\n\ts_nop 0\n\tglobal_load_lds_dwordx4 %1, off\n\ts_mov_b32 m0, %0":"=&s"(keep):"v"(gsrc),"s"(lds_dst):"memory");}
__device__ __forceinline__ float max3f(float a,float b,float c){float r;asm("v_max3_f32 %0, %1, %2, %3":"=v"(r):"v"(a),"v"(b),"v"(c));return r;}
__device__ __forceinline__ float max2f(float a,float b){float r;asm("v_max_f32_e32 %0, %1, %2":"=v"(r):"v"(a),"v"(b));return r;}
__device__ __forceinline__ float fadd_s(float a,float b){float r;asm("v_add_f32_e32 %0, %1, %2":"=v"(r):"v"(a),"v"(b));return r;}
__device__ __forceinline__ float fsub_s(float a,float b){float r;asm("v_sub_f32_e32 %0, %1, %2":"=v"(r):"v"(a),"v"(b));return r;}
typedef float f32x2_t __attribute__((ext_vector_type(2))); typedef __bf16 bf16x2_t __attribute__((ext_vector_type(2)));
__device__ __forceinline__ unsigned cvtpk_s(float lo,float hi){f32x2_t v={lo,hi};bf16x2_t b=__builtin_convertvector(v,bf16x2_t);return __builtin_bit_cast(unsigned,b);}
#define WAIT_BAR(N) asm volatile("s_waitcnt vmcnt(" #N ") lgkmcnt(0)\n\ts_barrier":::"memory")

__device__ __forceinline__ void qkt(f32x16&p0,f32x16&p1,const char*Kslot,const bf16x8*qr,const f32x16&negm,int r32,int hi){
  const char*kb=Kslot+hi*1024+r32*16;
  #pragma unroll
  for(int d0=0;d0<4;++d0){
    const bf16x8 b0=*reinterpret_cast<const bf16x8*>(kb+d0*2048);
    const bf16x8 b1=*reinterpret_cast<const bf16x8*>(kb+d0*2048+512);
    if(d0==0){p0=__builtin_amdgcn_mfma_f32_32x32x16_bf16(b0,qr[0],negm,0,0,0);p1=__builtin_amdgcn_mfma_f32_32x32x16_bf16(b1,qr[0],negm,0,0,0);}
    else{p0=__builtin_amdgcn_mfma_f32_32x32x16_bf16(b0,qr[d0],p0,0,0,0);p1=__builtin_amdgcn_mfma_f32_32x32x16_bf16(b1,qr[d0],p1,0,0,0);}}
}
typedef __attribute__((address_space(3))) const char* lds_cptr;
typedef short v4i16_t __attribute__((ext_vector_type(4)));
__device__ __forceinline__ void kload8(bf16x8*kf,lds_cptr kp){
  kf[0]=*(const __attribute__((address_space(3))) bf16x8*)(kp);      kf[1]=*(const __attribute__((address_space(3))) bf16x8*)(kp+512);
  kf[2]=*(const __attribute__((address_space(3))) bf16x8*)(kp+2048); kf[3]=*(const __attribute__((address_space(3))) bf16x8*)(kp+2560);
  kf[4]=*(const __attribute__((address_space(3))) bf16x8*)(kp+4096); kf[5]=*(const __attribute__((address_space(3))) bf16x8*)(kp+4608);
  kf[6]=*(const __attribute__((address_space(3))) bf16x8*)(kp+6144); kf[7]=*(const __attribute__((address_space(3))) bf16x8*)(kp+6656);
}
__device__ __forceinline__ void kload2(bf16x8*kf,lds_cptr kp,int j){ kf[2*j]=*(const __attribute__((address_space(3))) bf16x8*)(kp+j*2048); kf[2*j+1]=*(const __attribute__((address_space(3))) bf16x8*)(kp+j*2048+512); }
__device__ __forceinline__ s16x4 vtr(lds_cptr p){ return __builtin_bit_cast(s16x4,__builtin_amdgcn_ds_read_tr16_b64_v4i16((__attribute__((address_space(3))) v4i16_t*)p)); }
__device__ __forceinline__ float rowmax(const f32x16&p0,const f32x16&p1){
  float a=max3f(p0[0],p0[1],p1[0]),b=max3f(p0[2],p0[3],p1[1]);a=max3f(a,p1[2],p1[3]);
  #pragma unroll
  for(int r=4;r<16;r+=4){a=max3f(a,p0[r],p0[r+1]);b=max3f(b,p0[r+2],p0[r+3]);a=max3f(a,p1[r],p1[r+1]);b=max3f(b,p1[r+2],p1[r+3]);}
  const float m=max2f(a,b);
  auto rr=__builtin_amdgcn_permlane32_swap(__float_as_uint(m),__float_as_uint(m),false,false);
  return max2f(__uint_as_float(rr[0]),__uint_as_float(rr[1]));
}
__device__ __forceinline__ void pv(f32x16*o,int vb,bf16x8 pa0,bf16x8 pa1,bf16x8 pa2,bf16x8 pa3){
  #pragma unroll
  for(int d0=0;d0<2;++d0){s16x4 lo[4],hi[4];
    #pragma unroll
    for(int ks=0;ks<4;++ks){
      asm volatile("ds_read_b64_tr_b16 %0,%1 offset:%c2":"=&v"(lo[ks]):"v"(vb),"i"(d0*4096+ks*1024):"memory");
      asm volatile("ds_read_b64_tr_b16 %0,%1 offset:%c2":"=&v"(hi[ks]):"v"(vb),"i"(d0*4096+ks*1024+512):"memory");}
    asm volatile("s_waitcnt lgkmcnt(0)":::"memory");SBAR();
    #define PK(k) (bf16x8){lo[k][0],lo[k][1],lo[k][2],lo[k][3],hi[k][0],hi[k][1],hi[k][2],hi[k][3]}
    o[d0]=__builtin_amdgcn_mfma_f32_32x32x16_bf16(pa0,PK(0),o[d0],0,0,0);
    o[d0]=__builtin_amdgcn_mfma_f32_32x32x16_bf16(pa1,PK(1),o[d0],0,0,0);
    o[d0]=__builtin_amdgcn_mfma_f32_32x32x16_bf16(pa2,PK(2),o[d0],0,0,0);
    o[d0]=__builtin_amdgcn_mfma_f32_32x32x16_bf16(pa3,PK(3),o[d0],0,0,0);
    #undef PK
  }
}

#ifndef ATTN_STORE16
#define ATTN_STORE16(p,v) (*(u32x4*)(p)=(v))
#endif
template<int THRL> __device__ __forceinline__ void attn_unit(int b,int h,int hv,int ocol,int qb,const bf16*Q,const bf16*__restrict__ K,const bf16*__restrict__ V,bf16*O,char*shm){
  const int tid=threadIdx.x,lane=tid&63,r32=lane&31,hi=lane>>5; const int wid=__builtin_amdgcn_readfirstlane(tid>>6);
  const long rowbase=(long)b*SEQ; const int q0=qb*QB;
  const bf16*Qw=Q+(rowbase+q0+wid*QBLK)*DM+h*D;
  const bf16*Kh=K+rowbase*DM+h*D,*Vh=V+rowbase*DM+hv*D;
  const unsigned lds0=(unsigned)(uintptr_t)shm;
  float*wsf=(float*)(shm+LDS_WS)+wid*64;
  const bf16*ksrc=Kh+(long)lane*DM+wid*8;
  const bf16*vsrc=Vh+(long)(16*(wid&3)+(lane>>2))*DM+(wid>>2)*32+(lane&3)*8;
  const unsigned kdst=lds0+LDS_K+wid*1024, vdst=lds0+LDS_V+wid*1024;
  #define DMA_K(t,slot) glds16(ksrc+(long)(t)*KVBLK*DM,(unsigned)__builtin_amdgcn_readfirstlane(kdst+(slot)))
  #define DMA_V(t,slot) glds16(vsrc+(long)(t)*KVBLK*DM,(unsigned)__builtin_amdgcn_readfirstlane(vdst+(slot)))
  const int vb0=(int)(lds0+LDS_V)+((lane>>4)&1)*32+(lane&3)*8+(4*hi+((lane&15)>>2))*64;
  const char*Kbase=shm+LDS_K; bf16x8 kf[8];
  const lds_cptr shm3=(lds_cptr)shm; const lds_cptr kp0=shm3+LDS_K+hi*1024+r32*16; const lds_cptr vp0=shm3+LDS_V+((lane>>4)&1)*32+(lane&3)*8+(4*hi+((lane&15)>>2))*64;
  const int NT=(q0+QB)/KVBLK;
  DMA_K(0,0);DMA_V(0,0);DMA_K(1,SLOTB);
  bf16x8 qr[4];
  #pragma unroll
  for(int d0=0;d0<4;++d0)qr[d0]=*reinterpret_cast<const bf16x8*>(&Qw[(long)r32*DM+d0*16+hi*8]);
  float mhat=0.f,l_reg=0.f;f32x16 o[2];o[0]=f32x16{};o[1]=f32x16{};f32x16 negm=f32x16{};asm volatile("":"+v"(negm));
  const int qrel=wid*QBLK+r32;
  #define CMASK(P0,P1,t) do{int jb_=(t)-(NT-4); if(jb_>=0)cmask(P0,P1,jb_,qrel,hi);}while(0)
  bool resc=false;
  #define START(P0,P1) do{ const float rm=rowmax(P0,P1); resc=false; \
    { const float dl=rm; mhat=fadd_s(mhat,dl); \
      _Pragma("unroll") for(int r=0;r<16;++r){P0[r]=fsub_s(P0[r],dl);P1[r]=fsub_s(P1[r],dl);} \
      _Pragma("unroll") for(int r=0;r<16;++r)negm[r]=-mhat; asm volatile("":"+v"(negm)); } \
    _Pragma("unroll") for(int r=0;r<16;++r)P0[r]=__builtin_amdgcn_exp2f(P0[r]); }while(0)
  #define RESC() do{ if(resc){ asm volatile("s_waitcnt lgkmcnt(0)":::"memory"); \
      _Pragma("unroll") for(int d_=0;d_<2;++d_) _Pragma("unroll") for(int r=0;r<16;++r)o[d_][r]*=wsf[crow(r,hi)]; } }while(0)
  f32x16 pA0,pA1,pB0,pB1;
  int sl_prev=0,sl_cur=0,sl_next=SLOTB;
  #define ROT() do{sl_prev=sl_cur;sl_cur=sl_next;sl_next=(sl_next==(NSLOT-1)*SLOTB)?0:sl_next+SLOTB;}while(0)
  DMA_K(2,2*SLOTB);
  WAIT_BAR(3);
  qkt(pA0,pA1,Kbase,qr,negm,r32,hi);asm volatile("s_nop 15\n\ts_nop 7":"+v"(pA0),"+v"(pA1));CMASK(pA0,pA1,0);
  START(pA0,pA1);
  _Pragma("unroll") for(int r=0;r<16;++r)pA1[r]=__builtin_amdgcn_exp2f(pA1[r]);
  WAIT_BAR(0);
  DMA_K(3,0);DMA_V(1,SLOTB);
  ROT();
  kload8(kf,kp0+sl_cur);
  WAIT_BAR(2);
  s16x4 vlo[8],vhi[8]; u32x4 pw0,pw1,pw2,pw3;
  #define PKW(P,B) cvtpk_s(P[B],P[B+1])
  #define PAF(k) __builtin_bit_cast(bf16x8,pw##k)
  #define VFR(i) (bf16x8){vlo[i][0],vlo[i][1],vlo[i][2],vlo[i][3],vhi[i][0],vhi[i][1],vhi[i][2],vhi[i][3]}
  #define PIN(x) asm volatile("":"+v"(x))
  #define MX3(a,b,c) __builtin_fmaxf(__builtin_fmaxf((a),(b)),(c))
  #define GAPA(MF,A0,A1,A2,A3,W0,W1,PW) do{ MF; sacc+=A0; sacc+=A1; sacc+=A2; sacc+=A3; PIN(sacc); W0; W1; PIN(PW); SBAR(); }while(0)
  #define EX(v) __builtin_amdgcn_exp2f(v)
  #define GAPB(MF,X,B) do{ MF; X[B]=EX(X[B]); X[B+1]=EX(X[B+1]); X[B+2]=EX(X[B+2]); X[B+3]=EX(X[B+3]); PIN(X); SBAR(); }while(0)
  #define VRD(i) do{ vlo[i]=vtr(vp_+(((i)>>2)*4096+((i)&3)*1024)); vhi[i]=vtr(vp_+(((i)>>2)*4096+((i)&3)*1024+512)); }while(0)
  #define KRD(G,j) do{ if(G){ kload2(kf,kp0+sl_next,j); SBAR(); } }while(0)
  #define STEP(C0,C1,P0,P1,t,GK,GV,GL) do{ SBAR(); \
    const lds_cptr vp_=vp0+sl_prev; \
    VRD(0); SBAR(); float sacc=(P0[0]+P0[1]); \
    GAPA(C0=__builtin_amdgcn_mfma_f32_32x32x16_bf16(kf[0],qr[0],negm,0,0,0), P0[2],P0[3],P0[4],P0[5],     pw0[0]=PKW(P0,0), pw0[1]=PKW(P0,2), pw0); \
    VRD(4); SBAR(); GAPA(C1=__builtin_amdgcn_mfma_f32_32x32x16_bf16(kf[1],qr[0],negm,0,0,0), P0[6],P0[7],P0[8],P0[9],     pw0[2]=PKW(P0,4), pw0[3]=PKW(P0,6), pw0); \
    VRD(1); SBAR(); GAPA(C0=__builtin_amdgcn_mfma_f32_32x32x16_bf16(kf[2],qr[1],C0,0,0,0),   P0[10],P0[11],P0[12],P0[13], pw1[0]=PKW(P0,8), pw1[1]=PKW(P0,10), pw1); \
    VRD(5); SBAR(); GAPA(C1=__builtin_amdgcn_mfma_f32_32x32x16_bf16(kf[3],qr[1],C1,0,0,0),   P0[14],P0[15],P1[0],P1[1],   pw1[2]=PKW(P0,12),pw1[3]=PKW(P0,14), pw1); \
    VRD(2); SBAR(); GAPA(C0=__builtin_amdgcn_mfma_f32_32x32x16_bf16(kf[4],qr[2],C0,0,0,0),   P1[2],P1[3],P1[4],P1[5],     pw2[0]=PKW(P1,0), pw2[1]=PKW(P1,2), pw2); \
    VRD(6); SBAR(); GAPA(C1=__builtin_amdgcn_mfma_f32_32x32x16_bf16(kf[5],qr[2],C1,0,0,0),   P1[6],P1[7],P1[8],P1[9],     pw2[2]=PKW(P1,4), pw2[3]=PKW(P1,6), pw2); \
    VRD(3); SBAR(); GAPA(C0=__builtin_amdgcn_mfma_f32_32x32x16_bf16(kf[6],qr[3],C0,0,0,0),   P1[10],P1[11],P1[12],P1[13], pw3[0]=PKW(P1,8), pw3[1]=PKW(P1,10), pw3); \
    VRD(7); SBAR(); GAPA(C1=__builtin_amdgcn_mfma_f32_32x32x16_bf16(kf[7],qr[3],C1,0,0,0),   P1[14],P1[15],0.f,0.f,       pw3[2]=PKW(P1,12),pw3[3]=PKW(P1,14), pw3); \
    l_reg+=sacc; \
    if(GK){DMA_K((t)+3,sl_cur);} if(GV){DMA_V((t)+1,sl_next);} \
    CMASK(C0,C1,t); \
    { float a=MX3(C0[0],C0[1],C1[0]),b=MX3(C0[2],C0[3],C1[1]); a=MX3(a,C1[2],C1[3]); \
      _Pragma("unroll") for(int r=4;r<16;r+=4){a=MX3(a,C0[r],C0[r+1]);b=MX3(b,C0[r+2],C0[r+3]);a=MX3(a,C1[r],C1[r+1]);b=MX3(b,C1[r+2],C1[r+3]);} \
      float rm=__builtin_fmaxf(a,b); { auto rr=__builtin_amdgcn_permlane32_swap(__float_as_uint(rm),__float_as_uint(rm),false,false); rm=__builtin_fmaxf(__uint_as_float(rr[0]),__uint_as_float(rr[1])); } \
      resc=false; \
      if(__builtin_expect(__any(rm>(float)THRL),0)){ const float dl=__builtin_fmaxf(rm,0.f); mhat+=dl; \
        _Pragma("unroll") for(int r=0;r<16;++r){C0[r]-=dl;C1[r]-=dl;} \
        _Pragma("unroll") for(int r=0;r<16;++r)negm[r]=-mhat; asm volatile("":"+v"(negm)); \
        const float f=__builtin_amdgcn_exp2f(-dl); l_reg*=f; if(hi==0)wsf[r32]=f; resc=true; } } \
    SBAR(); \
    GAPB(o[0]=__builtin_amdgcn_mfma_f32_32x32x16_bf16(PAF(0),VFR(0),o[0],0,0,0), C0,0); \
    GAPB(o[1]=__builtin_amdgcn_mfma_f32_32x32x16_bf16(PAF(0),VFR(4),o[1],0,0,0), C0,4); \
    KRD(GL,0); GAPB(o[0]=__builtin_amdgcn_mfma_f32_32x32x16_bf16(PAF(1),VFR(1),o[0],0,0,0), C0,8); \
    KRD(GL,1); GAPB(o[1]=__builtin_amdgcn_mfma_f32_32x32x16_bf16(PAF(1),VFR(5),o[1],0,0,0), C0,12); \
    KRD(GL,2); GAPB(o[0]=__builtin_amdgcn_mfma_f32_32x32x16_bf16(PAF(2),VFR(2),o[0],0,0,0), C1,0); \
    KRD(GL,3); GAPB(o[1]=__builtin_amdgcn_mfma_f32_32x32x16_bf16(PAF(2),VFR(6),o[1],0,0,0), C1,4); \
    GAPB(o[0]=__builtin_amdgcn_mfma_f32_32x32x16_bf16(PAF(3),VFR(3),o[0],0,0,0), C1,8); \
    GAPB(o[1]=__builtin_amdgcn_mfma_f32_32x32x16_bf16(PAF(3),VFR(7),o[1],0,0,0), C1,12); \
    }while(0)
  int t=1;
  #undef CMASK
  #define CMASK(P0,P1,t) do{}while(0)
  for(;t+5<NT;t+=2){
    STEP(pB0,pB1,pA0,pA1,t,true,true,true);     WAIT_BAR(2); RESC(); ROT();
    STEP(pA0,pA1,pB0,pB1,t+1,true,true,true);   WAIT_BAR(2); RESC(); ROT();
  }
  #undef CMASK
  #define CMASK(P0,P1,t) do{int jb_=(t)-(NT-4); if(jb_>=0)cmask(P0,P1,jb_,qrel,hi);}while(0)
  #define ENDW(tt) do{ if((tt)+3<NT){WAIT_BAR(2);} else if((tt)+2<NT){WAIT_BAR(1);} else {WAIT_BAR(0);} }while(0)
  for(;t+1<NT;t+=2){
    STEP(pB0,pB1,pA0,pA1,t,(t+3<NT),(t+1<NT),(t+1<NT));       ENDW(t);   RESC(); ROT();
    STEP(pA0,pA1,pB0,pB1,t+1,(t+4<NT),(t+2<NT),(t+2<NT));     ENDW(t+1); RESC(); ROT();
  }
  STEP(pB0,pB1,pA0,pA1,NT-1,false,false,false); RESC();
  { float sacc=pB0[0]+pB0[1]; _Pragma("unroll") for(int r=2;r<16;++r)sacc+=pB0[r]; _Pragma("unroll") for(int r=0;r<16;++r)sacc+=pB1[r]; l_reg+=sacc;
    pw0=(u32x4){PKW(pB0,0),PKW(pB0,2),PKW(pB0,4),PKW(pB0,6)};pw1=(u32x4){PKW(pB0,8),PKW(pB0,10),PKW(pB0,12),PKW(pB0,14)};pw2=(u32x4){PKW(pB1,0),PKW(pB1,2),PKW(pB1,4),PKW(pB1,6)};pw3=(u32x4){PKW(pB1,8),PKW(pB1,10),PKW(pB1,12),PKW(pB1,14)};
    SBAR(); pv(o,vb0+sl_cur,PAF(0),PAF(1),PAF(2),PAF(3)); }
  #undef PKW
  #undef PAF
  #undef VFR
  #undef PIN
  #undef MX3
  #undef GAPA
  #undef GAPB
  #undef EX
  #undef VRD
  #undef KRD
  #undef STEP
  #undef ENDW
  {auto rr=__builtin_amdgcn_permlane32_swap(__float_as_uint(l_reg),__float_as_uint(l_reg),false,false);l_reg=__uint_as_float(rr[0])+__uint_as_float(rr[1]);}
  if(hi==0)wsf[32+r32]=l_reg;asm volatile("s_waitcnt lgkmcnt(0)":::"memory");
  float rli[16];
  #pragma unroll
  for(int r=0;r<16;++r)rli[r]=__builtin_amdgcn_rcpf(wsf[32+crow(r,hi)]);
  bf16*Ow=O+(rowbase+q0+wid*QBLK)*OP+ocol;
  { bf16*stg=(bf16*)(shm+LDS_OST)+wid*2048;
    #pragma unroll
    for(int r=0;r<16;++r){const int orow=crow(r,hi);
      #pragma unroll
      for(int d0=0;d0<2;++d0)stg[orow*64+d0*32+r32]=__float2bfloat16(o[d0][r]*rli[r]);}
    asm volatile("s_waitcnt lgkmcnt(0)":::"memory");
    #pragma unroll
    for(int i=0;i<4;++i){const int row=i*8+(lane>>3),ch=lane&7; const u32x4 v=*(const u32x4*)(stg+row*64+ch*8); ATTN_STORE16(Ow+(long)row*OP+ch*8,v);} }
  asm volatile("s_waitcnt lgkmcnt(0)\n\ts_barrier":::"memory");
  #undef DMA_K
  #undef DMA_V
  #undef CMASK
  #undef START
  #undef RESC
  #undef ROT
}
constexpr int ATTN_LDS_BYTES=LDS_BYTES;
struct AttnTensors { const bf16* Q; const bf16* K; const bf16* V; bf16* O; };
struct AttnUnit { int combo; int qb; };
struct StaticOrder {
  int vcu;
  __device__ __forceinline__ explicit StaticOrder(int vcu_):vcu(vcu_){}
  __device__ __forceinline__ bool next(int i,AttnUnit&u)const{ if(i>=4||vcu>=256)return false; const int s=vcu&3; u.combo=vcu>>2; u.qb=(i==0)?s:(i==1)?7-s:(i==2)?8+s:15-s; return true; }
};
template<class Sched,int THRL=8> __device__ __forceinline__ void attn_phase(char*lds,const AttnTensors&T,const Sched&S){
  AttnUnit u;
  for(int i=0;S.next(i,u);++i){ const int vh=u.combo&1, mp=(u.combo>>1)&1, h=(u.combo>>2)&7, b=u.combo>>5;
    attn_unit<THRL>(b,2*h+mp,2*h+vh,h*256+mp*128+vh*64,u.qb,T.Q,T.K,T.V,T.O,lds); }
}
#undef SBAR
#undef WAIT_BAR
}

constexpr int NWAVES = 8;
#ifndef MK_N_LAUNCHES
#define MK_N_LAUNCHES 1
#endif
constexpr int N_PHASES = 10;
constexpr int N_LAUNCHES = MK_N_LAUNCHES;
static_assert(N_LAUNCHES == 1 || N_LAUNCHES == N_PHASES, "MK_N_LAUNCHES is 1 or N_PHASES");

constexpr int DMODEL = 2048, SEQ = 4096, NBATCH = 2, MPR = NBATCH * SEQ, DBATCH = 8, DSEQ = 8, MSM = DBATCH * DSEQ, MREAL = MPR + MSM, MPAD = 8448;
constexpr int DIN = 5120, DFF = 5632, DUP = 2 * DFF, NH = 8, HD = 128;
constexpr int NPG = 128, PAGE = 128;
constexpr int NSPLIT = 32, PPS = NPG / NSPLIT;
constexpr float EPS = 1e-6f, LAM_INIT = 0.2f, SUBLN_SCALE = 1.0f - LAM_INIT;
constexpr float C2 = 0.125f * 1.4426950408889634f;

constexpr size_t OUT_YP = 0, OUT_YS = OUT_YP + (size_t)MPR * DMODEL, OUT_KP = OUT_YS + (size_t)MSM * DMODEL, OUT_VP = OUT_KP + (size_t)MPR * 1024,
                 OUT_CP = OUT_VP + (size_t)MPR * 1024, OUT_KS = OUT_CP + (size_t)NBATCH * 2 * DUP, OUT_VS = OUT_KS + (size_t)MSM * 1024,
                 OUT_CS = OUT_VS + (size_t)MSM * 1024, OUT_GV = OUT_CS + (size_t)DBATCH * 2 * DUP, OUT_END = OUT_GV + (size_t)MSM * 1024;

constexpr size_t MiB = 1u << 20;
constexpr size_t al(size_t x) { return (x + MiB - 1) / MiB * MiB; }
constexpr size_t WS_CTL = 0, CTL_ZERO_BYTES = MiB;
constexpr size_t WS_WIN = MiB;
constexpr size_t WS_WOUT = WS_WIN + al((size_t)DIN * DMODEL * 2);
constexpr size_t WS_WUP = WS_WOUT + al((size_t)DMODEL * DMODEL * 2);
constexpr size_t WS_WDN = WS_WUP + al((size_t)DUP * DMODEL * 2);
constexpr size_t WS_XN = WS_WDN + al((size_t)DMODEL * DFF * 2);
constexpr size_t ACT1 = al((size_t)MPAD * 1024 * 2);
constexpr size_t WS_U = WS_XN + al((size_t)MPAD * DMODEL * 2);
constexpr size_t WS_VA = WS_U + ACT1, WS_Q = WS_VA + ACT1, WS_K = WS_Q + ACT1, WS_V = WS_K + ACT1;
constexpr size_t WS_O4 = WS_V + ACT1;
constexpr size_t WS_MIXIN = WS_O4 + al((size_t)MPAD * 2048 * 2);
constexpr size_t WS_MIX = WS_MIXIN + al((size_t)MPAD * 2048 * 2);
constexpr size_t WS_H = WS_MIX + al((size_t)MPAD * 2048 * 4);
constexpr size_t WS_HN = WS_H + al((size_t)MPAD * 2048 * 4);
constexpr size_t WS_UP = WS_HN + al((size_t)MPAD * 2048 * 2);
constexpr size_t WS_G = WS_UP + al((size_t)MPAD * DUP * 2);
constexpr size_t WS_Y = WS_G + al((size_t)MPAD * DFF * 2);
constexpr size_t WS_DPART = WS_Y + al((size_t)MPAD * 2048 * 4);
constexpr size_t WS_DML = WS_DPART + al((size_t)DBATCH * NH * NSPLIT * 16 * 128 * 4);
constexpr size_t WS_END = WS_DML + MiB;
constexpr int CW_TMO = 0, CW_BAR = 4096;

constexpr int RING_OFF = 0, RING_BYTES = 131072;
constexpr int LDSCTL_OFF = RING_BYTES, MISC_OFF = LDSCTL_OFF + 320;
constexpr int LDS_BYTES = 147456;
static_assert(MISC_OFF + 128 <= LDS_BYTES, "LDS map");
#define GAS __attribute__((address_space(1)))
#define LAS __attribute__((address_space(3)))
typedef unsigned short bf16;
typedef unsigned v4u __attribute__((ext_vector_type(4)));
typedef float f32x4 __attribute__((ext_vector_type(4)));
typedef short bf16x8 __attribute__((ext_vector_type(8)));
typedef GAS unsigned gu32;
typedef GAS unsigned long long gu64;
#define RLX_AGENT __ATOMIC_RELAXED, __HIP_MEMORY_SCOPE_AGENT
#define LDS_WAIT() asm volatile("s_waitcnt lgkmcnt(0)" ::: "memory")
#define VM_WAIT() asm volatile("s_waitcnt vmcnt(0)" ::: "memory")
__device__ __forceinline__ unsigned long long rt() { return __builtin_amdgcn_s_memrealtime(); }
__device__ __forceinline__ unsigned f2bf(float f) { unsigned u = __builtin_bit_cast(unsigned, f); return (u + 0x7fffu + ((u >> 16) & 1u)) >> 16; }
__device__ __forceinline__ unsigned pk2(float lo, float hi) { return f2bf(lo) | (f2bf(hi) << 16); }

#define XB_TMO      128
#define XB_XCNT(j)  (256  + 64 * (j))
#define XB_XSUB(j)  (1280 + 64 * (j))
#define XB_XGEN(j)  (2304 + 64 * (j))
#define XB_TOP      3328
#define XB_TOPGEN   3392
#define XCD_BAR_WORDS 3456
#define XB_SPIN_CAP (1u << 18)

__device__ __forceinline__ unsigned xb_ld(unsigned* p)              { return __hip_atomic_load(p, __ATOMIC_RELAXED, __HIP_MEMORY_SCOPE_AGENT); }
__device__ __forceinline__ unsigned xb_add(unsigned* p, unsigned v) { return __hip_atomic_fetch_add(p, v, __ATOMIC_RELAXED, __HIP_MEMORY_SCOPE_AGENT); }
__device__ __forceinline__ unsigned xb_xcc_id() { return (unsigned)__builtin_amdgcn_s_getreg((3 << 11) | 20) & 0xFu; }
#define XB_SPIN(cond, bar) do { unsigned _sp = 0; while (cond) { __builtin_amdgcn_s_sleep(1); \
    if ((++_sp & 255u) == 0u) { if (xb_ld(&(bar)[XB_TMO])) break; if (_sp > XB_SPIN_CAP) { atomicAdd(&(bar)[XB_TMO], 1u); break; } } } } while (0)

struct XcdBarrier {
    unsigned* bar; unsigned x;
    volatile LAS unsigned* st;
};

__device__ __forceinline__ XcdBarrier xcd_barrier_post(unsigned* bar, volatile LAS unsigned* st) {
    XcdBarrier b; b.bar = bar; b.x = xb_xcc_id(); b.st = st;
    if (threadIdx.x == 0) (void)xb_add(&bar[XB_XCNT(b.x)], 1u);
    return b;
}
__device__ __forceinline__ void xcd_barrier_complete(unsigned* bar, unsigned x, unsigned& nloc, unsigned& nx) {
    const unsigned G = gridDim.x * gridDim.y * gridDim.z;
    unsigned sum, cnt, mine, sp = 0u;
    for (;;) {
        sum = 0u; cnt = 0u; mine = 0u;
#pragma unroll
        for (unsigned j = 0; j < 16; ++j) { const unsigned c = xb_ld(&bar[XB_XCNT(j)]); sum += c; cnt += (c > 0u) ? 1u : 0u; mine = (j == x) ? c : mine; }
        if (sum == G) break;
        __builtin_amdgcn_s_sleep(1);
        if ((++sp & 255u) == 0u) { if (xb_ld(&bar[XB_TMO])) break; if (sp > XB_SPIN_CAP) { atomicAdd(&bar[XB_TMO], 1u); break; } }
    }
    nloc = mine > 0u ? mine : 1u; nx = cnt > 0u ? cnt : 1u;
}

__device__ __forceinline__ void xcd_barrier(const XcdBarrier& b) {
    asm volatile("s_waitcnt vmcnt(0)" ::: "memory");
    __syncthreads();
    if (threadIdx.x == 0) {
        unsigned* bar = b.bar;
        __builtin_amdgcn_s_waitcnt(0);
        unsigned nloc = b.st[0], nx = b.st[1];
        if (nloc == 0u) { xcd_barrier_complete(bar, b.x, nloc, nx); b.st[0] = nloc; b.st[1] = nx; }
        const unsigned old = xb_add(&bar[XB_XSUB(b.x)], 1u);
        const unsigned gen = old / nloc;
        if (old + 1u == (gen + 1u) * nloc) {
            __builtin_amdgcn_fence(__ATOMIC_RELEASE, "agent");
            asm volatile("s_waitcnt vmcnt(0)" ::: "memory");
            const unsigned og = xb_add(&bar[XB_TOP], 1u);
            const unsigned tg = og / nx;
            if (og + 1u == (tg + 1u) * nx) xb_add(&bar[XB_TOPGEN], 1u);
            else XB_SPIN(xb_ld(&bar[XB_TOPGEN]) == tg, bar);
            __builtin_amdgcn_fence(__ATOMIC_ACQUIRE, "agent");
            xb_add(&bar[XB_XGEN(b.x)], 1u);
            asm volatile("s_waitcnt vmcnt(0)" ::: "memory");
        } else {
            XB_SPIN(xb_ld(&bar[XB_XGEN(b.x)]) == gen, bar);
            __builtin_amdgcn_fence(__ATOMIC_ACQUIRE, "agent");
            asm volatile("s_waitcnt vmcnt(0)" ::: "memory");
        }
    }
    __syncthreads();
}

typedef unsigned short v4us __attribute__((ext_vector_type(4)));
typedef float f32x2 __attribute__((ext_vector_type(2)));
typedef short s16x4 __attribute__((ext_vector_type(4)));
struct Frame {
    LAS unsigned char* lds;
    volatile LAS unsigned* MISC;
    gu32* ctl;
    int tid, lane, wave, vcu, G;
    const float *x_prompt, *x_sample, *cache_k, *cache_v, *state_conv; const int* page_table;
    const float *g_pre_mix, *w_in, *g_v_a, *w_s, *b_s, *lq1, *lk1, *lq2, *lk2, *g_subln, *w_out, *g_post_mix, *g_pre_ffn, *w_up, *w_conv, *b_conv, *w_down, *g_post_ffn;
    float* out;
    bf16 *Win_t, *Wout_t, *Wup_t, *Wdn_t, *XN, *U, *VA, *Q, *K, *V, *O4, *MIXIN, *HN, *UP, *GB;
    float *MIX, *H, *Y, *DPART, *DML;
};
__device__ __forceinline__ float wave_sum(float v) {
#pragma unroll
    for (int o = 1; o < 64; o <<= 1) v += __shfl_xor(v, o);
    return v;
}
__device__ __forceinline__ float wave_max(float v) {
#pragma unroll
    for (int o = 1; o < 64; o <<= 1) v = fmaxf(v, __shfl_xor(v, o));
    return v;
}
__device__ __forceinline__ float bf2f(unsigned short b) { return __uint_as_float((unsigned)b << 16); }
__device__ __forceinline__ float bflo(unsigned w) { return __uint_as_float(w << 16); }
__device__ __forceinline__ float bfhi(unsigned w) { return __uint_as_float(w & 0xffff0000u); }
__device__ __forceinline__ float gelu_f(float x) { return pg8::gelu_t(x); }
__device__ __forceinline__ float lam_of(const Frame& F) {
    float a = F.lq1[F.lane] * F.lk1[F.lane], b = F.lq2[F.lane] * F.lk2[F.lane];
    a = wave_sum(a); b = wave_sum(b);
    return __expf(a) - __expf(b) + LAM_INIT;
}

__device__ __forceinline__ void p0_transpose_item(const float* W, int K, int N, bf16* WT, LAS float* scr, int item, int lane) {
    const int nblk = N / 32, kb = item / nblk, nb = item % nblk, k0 = 64 * kb, n0 = 32 * nb;
#pragma unroll 8
    for (int i = 0; i < 32; ++i) { const int kk = 2 * i + (lane >> 5); scr[kk * 33 + (lane & 31)] = W[(size_t)(k0 + kk) * N + n0 + (lane & 31)]; }
    LDS_WAIT(); asm volatile("" ::: "memory");
    const int c = lane & 7;
#pragma unroll
    for (int j = 0; j < 4; ++j) { const int n = (lane >> 3) + 8 * j; const LAS float* s = scr + (8 * c) * 33 + n;
        v4u o; o.x = pk2(s[0 * 33], s[1 * 33]); o.y = pk2(s[2 * 33], s[3 * 33]); o.z = pk2(s[4 * 33], s[5 * 33]); o.w = pk2(s[6 * 33], s[7 * 33]);
        *(GAS v4u*)(WT + (size_t)(n0 + n) * K + k0 + 8 * c) = o; }
    LDS_WAIT(); asm volatile("" ::: "memory");
}
__device__ __forceinline__ void rms_row_to_bf16(const Frame& F, const float* xrow, const float* gain, bf16* orow) {
    const GAS f32x4* xr = (const GAS f32x4*)xrow + F.lane; const GAS f32x4* gr = (const GAS f32x4*)gain + F.lane;
    f32x4 v[8]; float s = 0.f;
#pragma unroll
    for (int j = 0; j < 8; ++j) { v[j] = xr[64 * j]; s += (v[j].x * v[j].x + v[j].y * v[j].y) + (v[j].z * v[j].z + v[j].w * v[j].w); }
    const float r = 1.0f / sqrtf(wave_sum(s) * (1.f / DMODEL) + EPS);
    GAS unsigned long long* o8 = (GAS unsigned long long*)orow + F.lane;
#pragma unroll
    for (int j = 0; j < 8; ++j) { const f32x4 g = gr[64 * j]; const f32x4 y = v[j] * r * g;
        o8[64 * j] = (unsigned long long)pk2(y.x, y.y) | ((unsigned long long)pk2(y.z, y.w) << 32); }
}
__device__ __forceinline__ void p0_prologue(const Frame& F) {
    LAS float* scr = (LAS float*)(F.lds + RING_OFF + F.wave * 16384);
    const int gw = F.vcu * NWAVES + F.wave, NGW = F.G * NWAVES;
    constexpr int I_IN = (DMODEL / 64) * (DIN / 32), I_OUT = (DMODEL / 64) * (DMODEL / 32), I_UP = (DMODEL / 64) * (DUP / 32), I_DN = (DFF / 64) * (DMODEL / 32);
    constexpr int NITEMS = I_IN + I_OUT + I_UP + I_DN;
    for (int it = gw; it < NITEMS; it += NGW) {
        int r = it;
        if (r < I_IN) { p0_transpose_item(F.w_in, DMODEL, DIN, F.Win_t, scr, r, F.lane); continue; } r -= I_IN;
        if (r < I_OUT) { p0_transpose_item(F.w_out, DMODEL, DMODEL, F.Wout_t, scr, r, F.lane); continue; } r -= I_OUT;
        if (r < I_UP) { p0_transpose_item(F.w_up, DMODEL, DUP, F.Wup_t, scr, r, F.lane); continue; } r -= I_UP;
        p0_transpose_item(F.w_down, DFF, DMODEL, F.Wdn_t, scr, r, F.lane);
    }
    for (int m = gw; m < MREAL; m += NGW) {
        const float* xr = m < MPR ? F.x_prompt + (size_t)m * DMODEL : F.x_sample + (size_t)(m - MPR) * DMODEL;
        rms_row_to_bf16(F, xr, F.g_pre_mix, F.XN + (size_t)m * DMODEL);
    }
}

constexpr int VPITCH = 288;
constexpr int DEC_VBUF = 32 * VPITCH;
__device__ __forceinline__ bf16x8 cvt8(f32x4 a, f32x4 b) { v4u w; w.x = pg8::cvt_pk_bf16(a[0], a[1]); w.y = pg8::cvt_pk_bf16(a[2], a[3]); w.z = pg8::cvt_pk_bf16(b[0], b[1]); w.w = pg8::cvt_pk_bf16(b[2], b[3]); return __builtin_bit_cast(bf16x8, w); }
__device__ __forceinline__ s16x4 tr16(LAS const unsigned char* p) { return __builtin_bit_cast(s16x4, __builtin_amdgcn_ds_read_tr16_b64_v4i16((LAS s16x4*)p)); }
__device__ __forceinline__ bf16x8 cat8(s16x4 lo, s16x4 hi) { return (bf16x8){lo[0], lo[1], lo[2], lo[3], hi[0], hi[1], hi[2], hi[3]}; }

__device__ __forceinline__ void decode_unit(const Frame& F, int b, int sp) {
    const int lane = F.lane, w = F.wave, r = lane & 15, g = lane >> 4;
    LAS unsigned char* vbuf = F.lds + RING_OFF + w * DEC_VBUF;
    bf16x8 qf[4];
    {
        const bf16* qrow = F.Q + (size_t)(MPR + b * DSEQ + (r & 7)) * 1024 + w * HD + 4 * g;
#pragma unroll
        for (int s = 0; s < 4; ++s) {
            const bool live = (r < 8) ? (s < 2) : (s >= 2);
            unsigned long long lo = 0ull, hi = 0ull;
            if (live) { lo = *(const unsigned long long*)(qrow + 32 * s); hi = *(const unsigned long long*)(qrow + 32 * s + 16); }
            v4u t; t.x = (unsigned)lo; t.y = (unsigned)(lo >> 32); t.z = (unsigned)hi; t.w = (unsigned)(hi >> 32);
            qf[s] = __builtin_bit_cast(bf16x8, t);
        }
    }
    float m_run = -INFINITY, l_run = 0.f;
    f32x4 o[8];
#pragma unroll
    for (int n = 0; n < 8; ++n) o[n] = (f32x4){0.f, 0.f, 0.f, 0.f};
    const int li = lane & 15, tq = li >> 2, tp = li & 3;
    LAS const unsigned char* trb = vbuf + (4 * g + tq) * VPITCH + tp * 8;
    for (int pi = 0; pi < PPS; ++pi) {
        const int phys = F.page_table[b * NPG + sp * PPS + pi];
        const float* Kp = F.cache_k + ((size_t)phys * PAGE) * 1024 + w * HD;
        const float* Vp = F.cache_v + ((size_t)phys * PAGE) * 1024 + w * HD;
        f32x4 st[8];
#pragma unroll
        for (int kb = 0; kb < 8; ++kb) {
            const float* kr = Kp + (size_t)(16 * kb + r) * 1024 + 4 * g;
            f32x4 acc = (f32x4){0.f, 0.f, 0.f, 0.f};
#pragma unroll
            for (int s = 0; s < 4; ++s) {
                const f32x4 a0 = *(const f32x4*)(kr + 32 * s), a1 = *(const f32x4*)(kr + 32 * s + 16);
                acc = __builtin_amdgcn_mfma_f32_16x16x32_bf16(cvt8(a0, a1), qf[s], acc, 0, 0, 0);
            }
            st[kb] = acc;
        }
        float mx = -INFINITY;
#pragma unroll
        for (int kb = 0; kb < 8; ++kb) mx = fmaxf(mx, fmaxf(fmaxf(st[kb][0], st[kb][1]), fmaxf(st[kb][2], st[kb][3])));
        mx = fmaxf(mx, __shfl_xor(mx, 16)); mx = fmaxf(mx, __shfl_xor(mx, 32));
        const float m_new = fmaxf(m_run, mx);
        const float fsc = __builtin_amdgcn_exp2f(m_run - m_new);
        float rs = 0.f;
#pragma unroll
        for (int kb = 0; kb < 8; ++kb) {
#pragma unroll
            for (int e = 0; e < 4; ++e) { const float p = __builtin_amdgcn_exp2f(st[kb][e] - m_new); st[kb][e] = p; rs += p; }
        }
        rs += __shfl_xor(rs, 16); rs += __shfl_xor(rs, 32);
        l_run = l_run * fsc + rs; m_run = m_new;
        float f4[4];
#pragma unroll
        for (int e = 0; e < 4; ++e) f4[e] = __shfl(fsc, 4 * g + e);
#pragma unroll
        for (int n = 0; n < 8; ++n) { o[n][0] *= f4[0]; o[n][1] *= f4[1]; o[n][2] *= f4[2]; o[n][3] *= f4[3]; }
        bf16x8 pa[4];
#pragma unroll
        for (int u = 0; u < 4; ++u) pa[u] = cvt8(st[2 * u], st[2 * u + 1]);
#pragma unroll
        for (int u = 0; u < 4; ++u) {
#pragma unroll
            for (int i = 0; i < 16; ++i) {
                const int kl = 2 * i + (lane >> 5);
                const f32x4 v = *(const f32x4*)(Vp + (size_t)(32 * u + kl) * 1024 + 4 * (lane & 31));
                f32x2 pk; pk.x = __uint_as_float(pg8::cvt_pk_bf16(v[0], v[1])); pk.y = __uint_as_float(pg8::cvt_pk_bf16(v[2], v[3]));
                *(LAS f32x2*)(vbuf + kl * VPITCH + (lane & 31) * 8) = pk;
            }
            asm volatile("s_waitcnt lgkmcnt(0)" ::: "memory");
#pragma unroll
            for (int n = 0; n < 8; ++n) {
                const s16x4 lo = tr16(trb + n * 32), hi = tr16(trb + 16 * VPITCH + n * 32);
                o[n] = __builtin_amdgcn_mfma_f32_16x16x32_bf16(pa[u], cat8(lo, hi), o[n], 0, 0, 0);
            }
            asm volatile("s_waitcnt lgkmcnt(0)" ::: "memory");
        }
    }
    const size_t pbase = ((size_t)(b * NH + w) * NSPLIT + sp) * 16;
    if (g == 0) { *(f32x2*)(F.DML + (pbase + r) * 2) = (f32x2){m_run, l_run}; }
#pragma unroll
    for (int n = 0; n < 8; ++n)
#pragma unroll
        for (int e = 0; e < 4; ++e) F.DPART[(pbase + 4 * g + e) * 128 + 16 * n + r] = o[n][e];
}

__device__ __forceinline__ void gmlp_unit(const Frame& F, int unit) {
    const int tid = F.tid, lane = F.lane, w = F.wave, r = lane & 15, g = lane >> 4;
    int b, h, row0, nvalid; bool samp = unit >= 512;
    if (!samp) { b = unit >> 8; const int c = (unit >> 3) & 31; h = unit & 7; row0 = b * SEQ + c * 128; nvalid = 128; }
    else { const int su = unit - 512; b = su >> 3; h = su & 7; row0 = MPR + b * DSEQ; nvalid = DSEQ; }
    LAS unsigned char* tile = F.lds + RING_OFF;
    {
        const int s = tid >> 2, part = tid & 3;
        v4u raw[4]; float vals[32]; float ss = 0.f;
        if (s < nvalid) {
            const bf16* src = F.VA + (size_t)(row0 + s) * 1024 + h * HD + part * 32;
#pragma unroll
            for (int i = 0; i < 4; ++i) raw[i] = *(const v4u*)(src + 8 * i);
        } else {
#pragma unroll
            for (int i = 0; i < 4; ++i) raw[i] = (v4u){0u, 0u, 0u, 0u};
        }
#pragma unroll
        for (int i = 0; i < 4; ++i) {
            vals[8 * i + 0] = bflo(raw[i].x); vals[8 * i + 1] = bfhi(raw[i].x); vals[8 * i + 2] = bflo(raw[i].y); vals[8 * i + 3] = bfhi(raw[i].y);
            vals[8 * i + 4] = bflo(raw[i].z); vals[8 * i + 5] = bfhi(raw[i].z); vals[8 * i + 6] = bflo(raw[i].w); vals[8 * i + 7] = bfhi(raw[i].w);
        }
#pragma unroll
        for (int i = 0; i < 32; ++i) ss += vals[i] * vals[i];
        ss += __shfl_xor(ss, 1); ss += __shfl_xor(ss, 2);
        const float rstd = 1.0f / sqrtf(ss * (1.0f / HD) + EPS);
        const float* gv = F.g_v_a + h * HD + part * 32;
#pragma unroll
        for (int i = 0; i < 32; ++i) vals[i] = vals[i] * rstd * gv[i];
        if (samp && s < nvalid) {
            float* go = F.out + OUT_GV + ((size_t)((b * DSEQ + s) * NH + h)) * HD + part * 32;
#pragma unroll
            for (int i = 0; i < 8; ++i) *(f32x4*)(go + 4 * i) = (f32x4){vals[4 * i], vals[4 * i + 1], vals[4 * i + 2], vals[4 * i + 3]};
        }
#pragma unroll
        for (int i = 0; i < 4; ++i) {
            v4u o; o.x = pk2(vals[8 * i], vals[8 * i + 1]); o.y = pk2(vals[8 * i + 2], vals[8 * i + 3]); o.z = pk2(vals[8 * i + 4], vals[8 * i + 5]); o.w = pk2(vals[8 * i + 6], vals[8 * i + 7]);
            *(LAS v4u*)(tile + s * VPITCH + part * 64 + 16 * i) = o;
        }
    }
    __syncthreads();
    if (16 * w < nvalid) {
        const int t = 16 * w + r;
        const int nu = samp ? 1 : (w >> 1) + 1;
        f32x4 o[8];
#pragma unroll
        for (int n = 0; n < 8; ++n) o[n] = (f32x4){0.f, 0.f, 0.f, 0.f};
        const int li = lane & 15, tq = li >> 2, tp = li & 3;
        LAS const unsigned char* trb = tile + (4 * g + tq) * VPITCH + tp * 8;
        const float* wrow = F.w_s + ((size_t)h * 128 + t) * 128;
        for (int u = 0; u < nu; ++u) {
            const int s0 = 32 * u + 4 * g, s1 = s0 + 16;
            f32x4 a0 = *(const f32x4*)(wrow + s0), a1 = *(const f32x4*)(wrow + s1);
#pragma unroll
            for (int e = 0; e < 4; ++e) { if (s0 + e > t) a0[e] = 0.f; if (s1 + e > t) a1[e] = 0.f; }
            const bf16x8 af = cvt8(a0, a1);
#pragma unroll
            for (int n = 0; n < 8; ++n) {
                const s16x4 lo = tr16(trb + (32 * u) * VPITCH + n * 32), hi = tr16(trb + (32 * u + 16) * VPITCH + n * 32);
                o[n] = __builtin_amdgcn_mfma_f32_16x16x32_bf16(af, cat8(lo, hi), o[n], 0, 0, 0);
            }
        }
#pragma unroll
        for (int e = 0; e < 4; ++e) {
            const int tt = 16 * w + 4 * g + e;
            if (tt < nvalid) {
                const float bias = F.b_s[h * 128 + tt];
                const bf16* up = F.U + (size_t)(row0 + tt) * 1024 + h * HD + r;
                bf16* op = F.MIXIN + (size_t)(row0 + tt) * 2048 + h * HD + r;
#pragma unroll
                for (int n = 0; n < 8; ++n) op[16 * n] = (bf16)f2bf(bf2f(up[16 * n]) * (o[n][e] + bias));
            }
        }
    }
    __syncthreads();
}

__device__ __forceinline__ void combine_prompt_row(const Frame& F, int m, float lam) {
    const int hh = F.lane >> 3, c = (F.lane & 7) * 16;
    const bf16* o1p = F.O4 + (size_t)m * 2048 + hh * 256 + c;
    const v4u a0 = *(const v4u*)o1p, a1 = *(const v4u*)(o1p + 8), b0 = *(const v4u*)(o1p + 128), b1 = *(const v4u*)(o1p + 136);
    float o[16];
    const unsigned aw[8] = {a0.x, a0.y, a0.z, a0.w, a1.x, a1.y, a1.z, a1.w}, bw[8] = {b0.x, b0.y, b0.z, b0.w, b1.x, b1.y, b1.z, b1.w};
    float ss = 0.f;
#pragma unroll
    for (int i = 0; i < 8; ++i) { o[2 * i] = bflo(aw[i]) - lam * bflo(bw[i]); o[2 * i + 1] = bfhi(aw[i]) - lam * bfhi(bw[i]); ss += o[2 * i] * o[2 * i] + o[2 * i + 1] * o[2 * i + 1]; }
    ss += __shfl_xor(ss, 1); ss += __shfl_xor(ss, 2); ss += __shfl_xor(ss, 4);
    const float rr = SUBLN_SCALE / sqrtf(ss * (1.0f / HD) + EPS);
    const float* gs = F.g_subln + c;
    v4u w0, w1;
    w0.x = pk2(o[0] * rr * gs[0], o[1] * rr * gs[1]); w0.y = pk2(o[2] * rr * gs[2], o[3] * rr * gs[3]); w0.z = pk2(o[4] * rr * gs[4], o[5] * rr * gs[5]); w0.w = pk2(o[6] * rr * gs[6], o[7] * rr * gs[7]);
    w1.x = pk2(o[8] * rr * gs[8], o[9] * rr * gs[9]); w1.y = pk2(o[10] * rr * gs[10], o[11] * rr * gs[11]); w1.z = pk2(o[12] * rr * gs[12], o[13] * rr * gs[13]); w1.w = pk2(o[14] * rr * gs[14], o[15] * rr * gs[15]);
    bf16* op = F.MIXIN + (size_t)m * 2048 + 1024 + hh * HD + c;
    *(v4u*)op = w0; *(v4u*)(op + 8) = w1;
}
__device__ __forceinline__ void combine_sample(const Frame& F, int task, float lam) {
    const int lane = F.lane, t = task & 7, h = (task >> 3) & 7, b = task >> 6;
    const int rowq = MPR + b * DSEQ + t;
    float om[2][2];
#pragma unroll
    for (int mp = 0; mp < 2; ++mp) {
        const int q = mp * 8 + t; const int sp = lane & 31;
        const size_t pb = ((size_t)(b * NH + h) * NSPLIT) * 16;
        const f32x2 ml = *(const f32x2*)(F.DML + ((pb + (size_t)sp * 16 + q) * 2));
        float sj = -INFINITY;
        if (lane <= t) {
            const bf16* qp = F.Q + (size_t)rowq * 1024 + h * HD + mp * 64; const bf16* kp = F.K + (size_t)(MPR + b * DSEQ + lane) * 1024 + h * HD + mp * 64;
            float s = 0.f;
            for (int d = 0; d < 64; ++d) s += bf2f(qp[d]) * bf2f(kp[d]);
            sj = s;
        }
        const float M = wave_max(fmaxf(ml.x, sj));
        const float wsp = (lane < 32) ? __builtin_amdgcn_exp2f(ml.x - M) : 0.f;
        const float pj = (lane <= t) ? __builtin_amdgcn_exp2f(sj - M) : 0.f;
        const float L = wave_sum(wsp * ml.y + pj);
        float a0 = 0.f, a1 = 0.f;
        for (int s = 0; s < NSPLIT; ++s) { const float ws = __shfl(wsp, s); const float* op = F.DPART + (pb + (size_t)s * 16 + q) * 128; a0 += ws * op[lane]; a1 += ws * op[lane + 64]; }
        for (int j = 0; j <= t; ++j) { const float p = __shfl(pj, j); const bf16* vp = F.V + (size_t)(MPR + b * DSEQ + j) * 1024 + h * HD; a0 += p * bf2f(vp[lane]); a1 += p * bf2f(vp[lane + 64]); }
        const float il = 1.0f / L;
        om[mp][0] = a0 * il; om[mp][1] = a1 * il;
    }
    const float o0 = om[0][0] - lam * om[1][0], o1 = om[0][1] - lam * om[1][1];
    const float ss = wave_sum(o0 * o0 + o1 * o1);
    const float rr = SUBLN_SCALE / sqrtf(ss * (1.0f / HD) + EPS);
    bf16* op = F.MIXIN + (size_t)rowq * 2048 + 1024 + h * HD;
    op[lane] = (bf16)f2bf(o0 * rr * F.g_subln[lane]); op[lane + 64] = (bf16)f2bf(o1 * rr * F.g_subln[lane + 64]);
}

__device__ __forceinline__ void postmix_row(const Frame& F, int m) {
    const float* xrow = m < MPR ? F.x_prompt + (size_t)m * DMODEL : F.x_sample + (size_t)(m - MPR) * DMODEL;
    const GAS f32x4* xr = (const GAS f32x4*)xrow + F.lane; const GAS f32x4* mr = (const GAS f32x4*)(F.MIX + (size_t)m * DMODEL) + F.lane;
    const GAS f32x4* g1 = (const GAS f32x4*)F.g_post_mix + F.lane; const GAS f32x4* g2 = (const GAS f32x4*)F.g_pre_ffn + F.lane;
    f32x4 v[8]; float s = 0.f;
#pragma unroll
    for (int j = 0; j < 8; ++j) { v[j] = mr[64 * j]; s += (v[j].x * v[j].x + v[j].y * v[j].y) + (v[j].z * v[j].z + v[j].w * v[j].w); }
    const float r1 = 1.0f / sqrtf(wave_sum(s) * (1.f / DMODEL) + EPS);
    GAS f32x4* hr = (GAS f32x4*)(F.H + (size_t)m * DMODEL) + F.lane;
    float s2 = 0.f;
#pragma unroll
    for (int j = 0; j < 8; ++j) { v[j] = xr[64 * j] + v[j] * r1 * g1[64 * j]; hr[64 * j] = v[j]; s2 += (v[j].x * v[j].x + v[j].y * v[j].y) + (v[j].z * v[j].z + v[j].w * v[j].w); }
    const float r2 = 1.0f / sqrtf(wave_sum(s2) * (1.f / DMODEL) + EPS);
    GAS unsigned long long* o8 = (GAS unsigned long long*)(F.HN + (size_t)m * DMODEL) + F.lane;
#pragma unroll
    for (int j = 0; j < 8; ++j) { const f32x4 y = v[j] * r2 * g2[64 * j]; o8[64 * j] = (unsigned long long)pk2(y.x, y.y) | ((unsigned long long)pk2(y.z, y.w) << 32); }
}
__device__ __forceinline__ void final_row(const Frame& F, int m) {
    const GAS f32x4* yr = (const GAS f32x4*)(F.Y + (size_t)m * DMODEL) + F.lane; const GAS f32x4* hr = (const GAS f32x4*)(F.H + (size_t)m * DMODEL) + F.lane;
    const GAS f32x4* g1 = (const GAS f32x4*)F.g_post_ffn + F.lane;
    float* orow = m < MPR ? F.out + OUT_YP + (size_t)m * DMODEL : F.out + OUT_YS + (size_t)(m - MPR) * DMODEL;
    GAS f32x4* o4 = (GAS f32x4*)orow + F.lane;
    f32x4 v[8]; float s = 0.f;
#pragma unroll
    for (int j = 0; j < 8; ++j) { v[j] = yr[64 * j]; s += (v[j].x * v[j].x + v[j].y * v[j].y) + (v[j].z * v[j].z + v[j].w * v[j].w); }
    const float r1 = 1.0f / sqrtf(wave_sum(s) * (1.f / DMODEL) + EPS);
#pragma unroll
    for (int j = 0; j < 8; ++j) o4[64 * j] = hr[64 * j] + v[j] * r1 * g1[64 * j];
}
__device__ __forceinline__ void ld8bf(const bf16* p, float (&o)[8]) { const v4u w = *(const v4u*)p; o[0] = bflo(w.x); o[1] = bfhi(w.x); o[2] = bflo(w.y); o[3] = bfhi(w.y); o[4] = bflo(w.z); o[5] = bfhi(w.z); o[6] = bflo(w.w); o[7] = bfhi(w.w); }
__device__ __forceinline__ void ld8f(const float* p, float (&o)[8]) { const f32x4 a = *(const f32x4*)p, b = *(const f32x4*)(p + 4); o[0] = a[0]; o[1] = a[1]; o[2] = a[2]; o[3] = a[3]; o[4] = b[0]; o[5] = b[1]; o[6] = b[2]; o[7] = b[3]; }
__device__ __forceinline__ void conv_tap(const Frame& F, int m, int k, int col, float (&o)[8]) {
    const bool samp = m >= MPR; const int t = samp ? ((m - MPR) & 7) : (m & (SEQ - 1));
    if (t - k >= 0) ld8bf(F.UP + (size_t)(m - k) * DUP + col, o);
    else if (samp) ld8f(F.state_conv + (size_t)(((m - MPR) >> 3) * 2 + (2 + t - k)) * DUP + col, o);
    else {
#pragma unroll
        for (int i = 0; i < 8; ++i) o[i] = 0.f;
    }
}
__device__ __forceinline__ void conv_task(const Frame& F, int task) {
    constexpr int NCC = DFF / 512;
    const int rb = task / NCC, cc = task % NCC, m0 = rb * 16, gc = cc * 512 + 8 * F.lane, vc = DFF + gc;
    float wg[3][8], wv[3][8], bg[8], bv[8];
#pragma unroll
    for (int j = 0; j < 3; ++j) { ld8f(F.w_conv + (size_t)j * DUP + gc, wg[j]); ld8f(F.w_conv + (size_t)j * DUP + vc, wv[j]); }
    ld8f(F.b_conv + gc, bg); ld8f(F.b_conv + vc, bv);
    float g1[8], g2[8], v1[8], v2[8], cg[8], cv[8];
    conv_tap(F, m0, 1, gc, g1); conv_tap(F, m0, 2, gc, g2); conv_tap(F, m0, 1, vc, v1); conv_tap(F, m0, 2, vc, v2);
    for (int i = 0; i < 16; ++i) {
        const int m = m0 + i;
        if (i > 0 && m >= MPR && ((m - MPR) & 7) == 0) { conv_tap(F, m, 1, gc, g1); conv_tap(F, m, 2, gc, g2); conv_tap(F, m, 1, vc, v1); conv_tap(F, m, 2, vc, v2); }
        ld8bf(F.UP + (size_t)m * DUP + gc, cg); ld8bf(F.UP + (size_t)m * DUP + vc, cv);
        float og[8];
#pragma unroll
        for (int e = 0; e < 8; ++e) {
            const float a = bg[e] + wg[0][e] * g2[e] + wg[1][e] * g1[e] + wg[2][e] * cg[e];
            const float c = bv[e] + wv[0][e] * v2[e] + wv[1][e] * v1[e] + wv[2][e] * cv[e];
            og[e] = gelu_f(a) * c;
            g2[e] = g1[e]; g1[e] = cg[e]; v2[e] = v1[e]; v1[e] = cv[e];
        }
        v4u w; w.x = pk2(og[0], og[1]); w.y = pk2(og[2], og[3]); w.z = pk2(og[4], og[5]); w.w = pk2(og[6], og[7]);
        *(v4u*)(F.GB + (size_t)m * DFF + gc) = w;
    }
}

struct Args { const void* in[24]; float* out; unsigned char* ws; int ph_lo, ph_hi; };
__global__ void __launch_bounds__(NWAVES * 64, 2) fwd_kernel(Args args) {
    extern __shared__ __attribute__((aligned(16))) unsigned char lds[];
    Frame F;
    F.lds = (LAS unsigned char*)lds;
    F.MISC = (volatile LAS unsigned*)(F.lds + MISC_OFF);
    F.tid = threadIdx.x; F.lane = F.tid & 63; F.wave = __builtin_amdgcn_readfirstlane(F.tid >> 6);
    F.G = gridDim.x; { const int bx = blockIdx.x; F.vcu = (F.G % 8 == 0) ? (bx % 8) * (F.G / 8) + bx / 8 : bx; }
    unsigned char* ws = args.ws;
    F.ctl = (gu32*)(ws + WS_CTL);
    F.x_prompt = (const float*)args.in[0]; F.x_sample = (const float*)args.in[1]; F.cache_k = (const float*)args.in[2]; F.cache_v = (const float*)args.in[3];
    F.state_conv = (const float*)args.in[4]; F.page_table = (const int*)args.in[5]; F.g_pre_mix = (const float*)args.in[6]; F.w_in = (const float*)args.in[7];
    F.g_v_a = (const float*)args.in[8]; F.w_s = (const float*)args.in[9]; F.b_s = (const float*)args.in[10]; F.lq1 = (const float*)args.in[11]; F.lk1 = (const float*)args.in[12];
    F.lq2 = (const float*)args.in[13]; F.lk2 = (const float*)args.in[14]; F.g_subln = (const float*)args.in[15]; F.w_out = (const float*)args.in[16]; F.g_post_mix = (const float*)args.in[17];
    F.g_pre_ffn = (const float*)args.in[18]; F.w_up = (const float*)args.in[19]; F.w_conv = (const float*)args.in[20]; F.b_conv = (const float*)args.in[21]; F.w_down = (const float*)args.in[22];
    F.g_post_ffn = (const float*)args.in[23]; F.out = args.out;
    F.Win_t = (bf16*)(ws + WS_WIN); F.Wout_t = (bf16*)(ws + WS_WOUT); F.Wup_t = (bf16*)(ws + WS_WUP); F.Wdn_t = (bf16*)(ws + WS_WDN);
    F.XN = (bf16*)(ws + WS_XN); F.U = (bf16*)(ws + WS_U); F.VA = (bf16*)(ws + WS_VA); F.Q = (bf16*)(ws + WS_Q); F.K = (bf16*)(ws + WS_K); F.V = (bf16*)(ws + WS_V);
    F.O4 = (bf16*)(ws + WS_O4); F.MIXIN = (bf16*)(ws + WS_MIXIN); F.HN = (bf16*)(ws + WS_HN); F.UP = (bf16*)(ws + WS_UP); F.GB = (bf16*)(ws + WS_G);
    F.MIX = (float*)(ws + WS_MIX); F.H = (float*)(ws + WS_H); F.Y = (float*)(ws + WS_Y); F.DPART = (float*)(ws + WS_DPART); F.DML = (float*)(ws + WS_DML);
    for (int u = F.tid; u < (LDS_BYTES - LDSCTL_OFF) / 4; u += NWAVES * 64) ((LAS unsigned*)(F.lds + LDSCTL_OFF))[u] = 0u;
    __syncthreads();
    XcdBarrier bar; bar.bar = (unsigned*)(F.ctl + CW_BAR); bar.x = 0; bar.st = nullptr;
    if (N_LAUNCHES == 1) bar = xcd_barrier_post((unsigned*)(F.ctl + CW_BAR), F.MISC + 8);
#define GRID_BAR() do { if (N_LAUNCHES == 1) xcd_barrier(bar); } while (0)
    const int lo = args.ph_lo, hi = args.ph_hi;
#define IN(k) (lo <= (k) && (k) < hi)
#define BOTH(k) (IN(k) && IN((k) + 1))
    const int gw = F.vcu * NWAVES + F.wave, NGW = F.G * NWAVES;

    if (IN(0)) { p0_prologue(F); if (BOTH(0)) GRID_BAR(); }

    if (IN(1)) {
        pg8::Gemm g{F.XN, F.Win_t, MPAD, DIN, DMODEL}; pg8::StaticOrder S; S.init(MPAD, DIN, F.G, (int)blockIdx.x);
        pg8::EpiIn E{F.U, F.VA, F.Q, F.K, F.V, F.out + OUT_KP, F.out + OUT_VP, F.out + OUT_KS, F.out + OUT_VS, C2};
        pg8::gemm_phase<pg8::EpiIn, pg8::StaticOrder, PG8_ALIGN, PG8_SP2>(F.lds + RING_OFF, g, S, E);
        if (BOTH(1)) GRID_BAR();
    }

    if (IN(2)) {
        for (int du = F.vcu; du < DBATCH * NSPLIT; du += F.G) decode_unit(F, du / NSPLIT, du % NSPLIT);
        __syncthreads();
        {
            const attn_body::AttnTensors AT{(const attn_body::bf16*)F.Q, (const attn_body::bf16*)F.K, (const attn_body::bf16*)F.V, (attn_body::bf16*)F.O4};
            for (int av = F.vcu; av < 256; av += F.G) { const attn_body::StaticOrder S(av); attn_body::attn_phase<attn_body::StaticOrder>((char*)lds + RING_OFF, AT, S); }
        }
        __syncthreads();
        for (int gu = F.vcu; gu < 512 + DBATCH * NH; gu += F.G) gmlp_unit(F, gu);
        if (BOTH(2)) GRID_BAR();
    }

    if (IN(3)) {
        const float lam = lam_of(F);
        for (int task = gw; task < DBATCH * NH * DSEQ; task += NGW) combine_sample(F, task, lam);
        for (int m = gw; m < MPR; m += NGW) combine_prompt_row(F, m, lam);
        if (BOTH(3)) GRID_BAR();
    }

    if (IN(4)) {
        pg8::Gemm g{F.MIXIN, F.Wout_t, MPAD, DMODEL, DMODEL}; pg8::StaticOrder S; S.init(MPAD, DMODEL, F.G, (int)blockIdx.x);
        pg8::EpiF32 E{F.MIX, DMODEL};
        pg8::gemm_phase<pg8::EpiF32, pg8::StaticOrder, PG8_ALIGN, PG8_SP2>(F.lds + RING_OFF, g, S, E);
        if (BOTH(4)) GRID_BAR();
    }

    if (IN(5)) { for (int m = gw; m < MREAL; m += NGW) postmix_row(F, m); if (BOTH(5)) GRID_BAR(); }

    if (IN(6)) {
        pg8::Gemm g{F.HN, F.Wup_t, MPAD, DUP, DMODEL}; pg8::StaticOrder S; S.init(MPAD, DUP, F.G, (int)blockIdx.x);
        pg8::EpiUp E{F.UP, F.out + OUT_CP, F.out + OUT_CS};
        pg8::gemm_phase<pg8::EpiUp, pg8::StaticOrder, PG8_ALIGN, PG8_SP2>(F.lds + RING_OFF, g, S, E);
        if (BOTH(6)) GRID_BAR();
    }

    if (IN(7)) { for (int task = gw; task < (MREAL / 16) * (DFF / 512); task += NGW) conv_task(F, task); if (BOTH(7)) GRID_BAR(); }

    if (IN(8)) {
        pg8::Gemm g{F.GB, F.Wdn_t, MPAD, DMODEL, DFF}; pg8::StaticOrder S; S.init(MPAD, DMODEL, F.G, (int)blockIdx.x);
        pg8::EpiF32 E{F.Y, DMODEL};
        pg8::gemm_phase<pg8::EpiF32, pg8::StaticOrder, PG8_ALIGN, PG8_SP2>(F.lds + RING_OFF, g, S, E);
        if (BOTH(8)) GRID_BAR();
    }

    if (IN(9)) { for (int m = gw; m < MREAL; m += NGW) final_row(F, m); }
#undef IN
#undef BOTH
}

extern "C" void kernel_launch(void* const* d_in, const int* in_sizes, int n_in, void* d_out, int out_size, void* d_ws, size_t ws_size, hipStream_t stream) {
    static int grid = 0;
    if (grid == 0) {
        if (n_in != 24 || (size_t)out_size != OUT_END || ws_size < WS_END) { fprintf(stderr, "kernel_launch: unexpected shapes: n_in %d out %d ws %zu (need %zu)\n", n_in, out_size, ws_size, (size_t)WS_END); grid = -1; return; }
        int dev = 0, cus = 0, per_cu = 0;
        if (hipGetDevice(&dev) != hipSuccess || hipDeviceGetAttribute(&cus, hipDeviceAttributeMultiprocessorCount, dev) != hipSuccess) { grid = -1; return; }
        if (hipFuncSetAttribute((const void*)fwd_kernel, hipFuncAttributeMaxDynamicSharedMemorySize, LDS_BYTES) != hipSuccess) { fprintf(stderr, "kernel_launch: hipFuncSetAttribute failed\n"); grid = -1; return; }
        if (hipOccupancyMaxActiveBlocksPerMultiprocessor(&per_cu, (const void*)fwd_kernel, NWAVES * 64, LDS_BYTES) != hipSuccess || per_cu < 1) { fprintf(stderr, "kernel_launch: occupancy query says %d blocks per CU\n", per_cu); }
        (void)hipGetLastError();
        grid = cus;
    }
    if (grid < 0) return;
    if (hipMemsetAsync((char*)d_ws + WS_CTL, 0, CTL_ZERO_BYTES, stream) != hipSuccess) return;
    Args a{};
    for (int i = 0; i < 24; ++i) a.in[i] = d_in[i];
    a.out = (float*)d_out; a.ws = (unsigned char*)d_ws;
    for (int li = 0; li < N_LAUNCHES; ++li) {
        a.ph_lo = (N_LAUNCHES == 1) ? 0 : li; a.ph_hi = (N_LAUNCHES == 1) ? N_PHASES : li + 1;
        hipLaunchKernelGGL(fwd_kernel, dim3(grid), dim3(NWAVES * 64), LDS_BYTES, stream, a);
        const hipError_t le = hipPeekAtLastError();
        if (le != hipSuccess) { fprintf(stderr, "kernel_launch: launch %d failed: %s\n", li, hipGetErrorName(le)); break; }
    }
}
```

```cpp
#define MK_N_LAUNCHES 1
#include <hip/hip_runtime.h>
#include <cstdio>
#include <cstdint>
namespace pg8 {
#define PG8_LAS __attribute__((address_space(3)))
typedef unsigned short bf16_t;
typedef short bf16x8 __attribute__((ext_vector_type(8)));
typedef float f32x4 __attribute__((ext_vector_type(4)));
typedef unsigned u32x4 __attribute__((ext_vector_type(4)));
constexpr int BM = 256, BK = 64, HALF = 128, HTB = HALF * BK * 2  , STAGE_BYTES = 8 * HTB, NXCD = 8, WGM = 8;

__host__ __device__ __forceinline__ int lds_byte(int r, int c) { const int st = (r >> 4) * 2 + (c >> 5), rr = r & 15, cc = c & 31, ob = rr * 64 + cc * 2; return st * 1024 + (ob ^ (((ob >> 9) & 1) << 5)); }
__host__ __device__ __forceinline__ void stage_rc(int b, int& R, int& C) { const int st = b / 1024, sb = b % 1024, swz = sb ^ (((sb >> 9) & 1) << 5); R = (st >> 1) * 16 + swz / 64; C = (st & 1) * 32 + (swz % 64) / 2; }
__host__ __device__ __forceinline__ int perm32(int rho) { const int n = rho >> 4, i = rho & 15; return 8 * (i >> 2) + 4 * n + (i & 3); }

struct Unit { int pm, pn, kofs; };
struct Gemm { const bf16_t* A; const bf16_t* Bt; int M, N, K, ld; };

struct StaticOrder {
    int nM, nN, nwg, G, c;
    __host__ __device__ void init(int M, int N, int G_, int c_) { nM = M / BM; nN = N / BM; nwg = nM * nN; G = G_; c = c_; }
    __host__ __device__ bool next(int i, Unit& u) const {
        const long L = (long)i * G + c; if (L >= nwg) return false;
        int wgid = (int)L; { const int q = nwg / NXCD, r = nwg % NXCD, xcd = wgid % NXCD, off = wgid / NXCD; wgid = (xcd < r ? xcd * (q + 1) : r * (q + 1) + (xcd - r) * q) + off; }
        const int nig = WGM * nN, gid = wgid / nig, fm = gid * WGM, gsz = (nM - fm) < WGM ? (nM - fm) : WGM;
        u.pm = fm + ((wgid % nig) % gsz); u.pn = (wgid % nig) / gsz; u.kofs = 0; return true;
    }
    __device__ __forceinline__ void a_ready(const Unit&) const {}
    __device__ __forceinline__ void done(const Unit&) const {}
};

__device__ __forceinline__ unsigned cvt_pk_bf16(float lo, float hi) { unsigned r; asm volatile("v_cvt_pk_bf16_f32 %0, %1, %2" : "=v"(r) : "v"(lo), "v"(hi)); return r; }
__device__ __forceinline__ float gelu_t(float x) {
    const float z = x * (1.0f + 0.044715f * x * x) * (-2.3022081985f);
    return x * __builtin_amdgcn_rcpf(1.0f + __builtin_amdgcn_exp2f(z));
}
__device__ __forceinline__ f32x4 gelu4(f32x4 v) { return (f32x4){gelu_t(v[0]), gelu_t(v[1]), gelu_t(v[2]), gelu_t(v[3])}; }
__device__ __forceinline__ u32x4 pack8(f32x4 v0, f32x4 v1) { u32x4 w; w.x = cvt_pk_bf16(v0[0], v0[1]); w.y = cvt_pk_bf16(v0[2], v0[3]); w.z = cvt_pk_bf16(v1[0], v1[1]); w.w = cvt_pk_bf16(v1[2], v1[3]); return w; }

constexpr int E_MP = 8192, E_MS = 64;

struct EpiIn {
    static constexpr bool PERM = true, AFTER_DRAIN = false;
    bf16_t *U, *VA, *Q, *K, *V; float *kp, *vp, *ks, *vs; float qscale;
    __device__ __forceinline__ void operator()(const f32x4 (&acc)[2][2][4][2], const Unit& u, int wr, int wc, int fr, int fq) const {
        const int t = u.pn >> 2;
        const int row0 = u.pm * BM + wr * 64 + fr, col0 = (u.pn & 3) * BM + wc * 32 + 8 * fq;
        bf16_t* base = t == 0 ? U : t == 1 ? VA : t == 2 ? Q : t == 3 ? K : V;
        float* fp = t == 3 ? kp : vp; float* fs = t == 3 ? ks : vs;
#pragma unroll
        for (int ai = 0; ai < 2; ++ai)
#pragma unroll
            for (int m = 0; m < 4; ++m) { const int row = row0 + ai * HALF + m * 16; bf16_t* rowp = base + (size_t)row * 1024 + col0;
                float* fo = nullptr; if (t >= 3) { if (row < E_MP) fo = fp + (size_t)row * 1024 + col0; else if (row < E_MP + E_MS) fo = fs + (size_t)(row - E_MP) * 1024 + col0; }
#pragma unroll
                for (int bj = 0; bj < 2; ++bj) { f32x4 v0 = acc[ai][bj][m][0], v1 = acc[ai][bj][m][1];
                    if (t < 2) { v0 = gelu4(v0); v1 = gelu4(v1); } else if (t == 2) { v0 = v0 * qscale; v1 = v1 * qscale; }
                    *(u32x4*)(rowp + bj * HALF) = pack8(v0, v1);
                    if (fo) { *(f32x4*)(fo + bj * HALF) = v0; *(f32x4*)(fo + bj * HALF + 4) = v1; } } }
    }
};
struct EpiF32 {
    static constexpr bool PERM = true, AFTER_DRAIN = false;
    float* O; int ldc;
    __device__ __forceinline__ void operator()(const f32x4 (&acc)[2][2][4][2], const Unit& u, int wr, int wc, int fr, int fq) const {
        const int row0 = u.pm * BM + wr * 64 + fr, col0 = u.pn * BM + wc * 32 + 8 * fq;
#pragma unroll
        for (int ai = 0; ai < 2; ++ai)
#pragma unroll
            for (int m = 0; m < 4; ++m) { float* rowp = O + (size_t)(row0 + ai * HALF + m * 16) * ldc + col0;
#pragma unroll
                for (int bj = 0; bj < 2; ++bj) { *(f32x4*)(rowp + bj * HALF) = acc[ai][bj][m][0]; *(f32x4*)(rowp + bj * HALF + 4) = acc[ai][bj][m][1]; } }
    }
};
struct EpiUp {
    static constexpr bool PERM = true, AFTER_DRAIN = false;
    bf16_t* UP; float *cp, *cs;
    __device__ __forceinline__ void operator()(const f32x4 (&acc)[2][2][4][2], const Unit& u, int wr, int wc, int fr, int fq) const {
        const int row0 = u.pm * BM + wr * 64 + fr, col0 = u.pn * BM + wc * 32 + 8 * fq;
#pragma unroll
        for (int ai = 0; ai < 2; ++ai)
#pragma unroll
            for (int m = 0; m < 4; ++m) { const int row = row0 + ai * HALF + m * 16; bf16_t* rowp = UP + (size_t)row * 11264 + col0;
                float* fo = nullptr;
                if (row < E_MP) { const int t = row & 4095; if (t >= 4094) fo = cp + (size_t)((row >> 12) * 2 + (t - 4094)) * 11264 + col0; }
                else if (row < E_MP + E_MS) { const int t = row & 7; if (t >= 6) fo = cs + (size_t)(((row - E_MP) >> 3) * 2 + (t - 6)) * 11264 + col0; }
#pragma unroll
                for (int bj = 0; bj < 2; ++bj) { const f32x4 v0 = acc[ai][bj][m][0], v1 = acc[ai][bj][m][1];
                    *(u32x4*)(rowp + bj * HALF) = pack8(v0, v1);
                    if (fo) { *(f32x4*)(fo + bj * HALF) = v0; *(f32x4*)(fo + bj * HALF + 4) = v1; } } }
    }
};

struct EpiPart {
    static constexpr bool PERM = true, AFTER_DRAIN = false;
    float* P; int klen;
    __device__ __forceinline__ void operator()(const f32x4 (&acc)[2][2][4][2], const Unit& u, int wr, int wc, int fr, int fq) const {
        if (wr != 0) return;
        const int ks = u.kofs / klen, col0 = u.pn * BM + wc * 32 + 8 * fq;
#pragma unroll
        for (int m = 0; m < 4; ++m) { float* rowp = P + ((size_t)ks * 64 + m * 16 + fr) * 2048 + col0;
#pragma unroll
            for (int bj = 0; bj < 2; ++bj) { *(f32x4*)(rowp + bj * HALF) = acc[0][bj][m][0]; *(f32x4*)(rowp + bj * HALF + 4) = acc[0][bj][m][1]; } }
    }
};
struct SplitKOrder {
    int idx, n, ntn, klen, pm;
    __device__ __forceinline__ bool next(int i, Unit& u) const { if (i > 0 || idx >= n) return false; u.pm = pm; u.pn = idx % ntn; u.kofs = (idx / ntn) * klen; return true; }
    __device__ __forceinline__ void a_ready(const Unit&) const {}
    __device__ __forceinline__ void done(const Unit&) const {}
};
template <class Epi, class Sched, bool ALIGN_EPI = false, bool SP2 = false>
__device__ __forceinline__ void gemm_phase(PG8_LAS unsigned char* lds, const Gemm g, const Sched& S, const Epi& E) {
    const int tid = threadIdx.x, wid = __builtin_amdgcn_readfirstlane(tid >> 6), lane = tid & 63, wr = wid >> 2, wc = wid & 3, fr = lane & 15, fq = lane >> 4;
    const int K = g.K, nt = K / BK;
    unsigned voffA[2], voffB[2];
#pragma unroll
    for (int i = 0; i < 2; ++i) { int R, C; stage_rc(tid * 16 + i * 8192, R, C); const int Rb = Epi::PERM ? ((R & ~31) + perm32(R & 31)) : R;
        voffA[i] = (unsigned)(R * g.ld + C) * 2u; voffB[i] = (unsigned)(Rb * g.ld + C) * 2u; }
    const size_t kstep = (size_t)(BK * 2);
    const size_t hstep = (size_t)HALF * g.ld * 2;
    const size_t tstep = 2 * hstep;
    const unsigned ldsw = (unsigned)wid * 1024u;
    const int aoff = lds_byte(wr * 64 + fr, fq * 8), boff = lds_byte(wc * 32 + fr, fq * 8);
#define PG8_SA(b, h) (((b) * 2 + (h)) * HTB)
#define PG8_SB(b, h) ((4 + (b) * 2 + (h)) * HTB)
#define PG8_STAGE(bufoff, gbase, voff) do { _Pragma("unroll") for (int _i = 0; _i < 2; ++_i) \
        __builtin_amdgcn_global_load_lds((const unsigned*)((const char*)(gbase) + (voff)[_i]), (PG8_LAS unsigned*)(lds + (bufoff) + ldsw + _i * 8192), 16, 0, 0); } while (0)
#define PG8_LDA(dst, b, h) do { _Pragma("unroll") for (int m = 0; m < 4; ++m) _Pragma("unroll") for (int k = 0; k < 2; ++k) dst[m][k] = *(const PG8_LAS bf16x8*)(lds + PG8_SA(b, h) + aoff + m * 2048 + k * 1024); } while (0)
#define PG8_LDB(dst, b, h) do { _Pragma("unroll") for (int n = 0; n < 2; ++n) _Pragma("unroll") for (int k = 0; k < 2; ++k) dst[n][k] = *(const PG8_LAS bf16x8*)(lds + PG8_SB(b, h) + boff + n * 2048 + k * 1024); } while (0)
#define PG8_MMA(ai, bj, At, Bt) do { __builtin_amdgcn_s_setprio(1); _Pragma("unroll") for (int m = 0; m < 4; ++m) _Pragma("unroll") for (int n = 0; n < 2; ++n) _Pragma("unroll") for (int k = 0; k < 2; ++k) \
        acc[ai][bj][m][n] = __builtin_amdgcn_mfma_f32_16x16x32_bf16(Bt[n][k], At[m][k], acc[ai][bj][m][n], 0, 0, 0); __builtin_amdgcn_s_setprio(0); } while (0)
#define PG8_WAIT_V(n) asm volatile("s_waitcnt vmcnt(" #n ")" ::: "memory")
#define PG8_WAIT_L(n) asm volatile("s_waitcnt lgkmcnt(" #n ")" ::: "memory")
#define PG8_BAR __builtin_amdgcn_s_barrier()
#define PG8_SCHED __builtin_amdgcn_sched_barrier(0)
    Unit cur, nxt; int ui = 0;
    if (!S.next(0, cur)) return;
    f32x4 acc[2][2][4][2];
#pragma unroll
    for (int a = 0; a < 2; ++a)
#pragma unroll
        for (int b = 0; b < 2; ++b)
#pragma unroll
            for (int m = 0; m < 4; ++m)
#pragma unroll
                for (int n = 0; n < 2; ++n) acc[a][b][m][n] = (f32x4){0.f, 0.f, 0.f, 0.f};
    bf16x8 At[4][2], B0[2][2], B1[2][2];
    const char* cA = (const char*)g.A + (size_t)cur.pm * tstep + (size_t)cur.kofs * 2; const char* cB = (const char*)g.Bt + (size_t)cur.pn * tstep + (size_t)cur.kofs * 2;
    S.a_ready(cur);
    if constexpr (SP2) {
        PG8_STAGE(PG8_SB(0, 0), cB, voffB); PG8_STAGE(PG8_SB(0, 1), cB + hstep, voffB); PG8_STAGE(PG8_SA(0, 0), cA, voffA); PG8_STAGE(PG8_SA(0, 1), cA + hstep, voffA);
        if (wr == 1) PG8_BAR;
        PG8_WAIT_V(2); PG8_BAR;
        PG8_STAGE(PG8_SB(1, 0), cB + kstep, voffB); PG8_STAGE(PG8_SA(1, 0), cA + kstep, voffA); PG8_STAGE(PG8_SB(1, 1), cB + hstep + kstep, voffB);
        PG8_WAIT_V(6); PG8_BAR;
    } else {
        PG8_STAGE(PG8_SB(0, 0), cB, voffB); PG8_STAGE(PG8_SA(0, 0), cA, voffA); PG8_STAGE(PG8_SB(0, 1), cB + hstep, voffB); PG8_STAGE(PG8_SA(0, 1), cA + hstep, voffA);
        if (wr == 1) PG8_BAR;
        PG8_WAIT_V(4); PG8_BAR;
        PG8_STAGE(PG8_SB(1, 0), cB + kstep, voffB); PG8_STAGE(PG8_SA(1, 0), cA + kstep, voffA); PG8_STAGE(PG8_SB(1, 1), cB + hstep + kstep, voffB);
        PG8_WAIT_V(6); PG8_BAR;
    }
    for (;;) {
        const bool has_next = S.next(ui + 1, nxt);
        const char* nA = has_next ? (const char*)g.A + (size_t)nxt.pm * tstep + (size_t)nxt.kofs * 2 : cA; const char* nB = has_next ? (const char*)g.Bt + (size_t)nxt.pn * tstep + (size_t)nxt.kofs * 2 : cB;
        for (int t = 0; t < nt; t += 2) {
            const bool last = (t == nt - 2);
            const char* a1 = cA + (size_t)(t + 1) * kstep;
            const char* a2 = last ? nA : cA + (size_t)(t + 2) * kstep; const char* b2 = last ? nB : cB + (size_t)(t + 2) * kstep;
            const char* a3 = a2 + kstep; const char* b3 = b2 + kstep;
            if (last && has_next) S.a_ready(nxt);
            if constexpr (SP2) {
            PG8_LDB(B0, 0, 0); PG8_LDB(B1, 0, 1); PG8_SCHED; PG8_LDA(At, 0, 0); PG8_STAGE(PG8_SA(1, 1), a1 + hstep, voffA);
            PG8_WAIT_V(8); PG8_WAIT_L(0); PG8_BAR; PG8_MMA(0, 0, At, B0); PG8_MMA(0, 1, At, B1); PG8_BAR; PG8_SCHED;
            PG8_LDA(At, 0, 1); PG8_STAGE(PG8_SB(0, 0), b2, voffB); PG8_STAGE(PG8_SB(0, 1), b2 + hstep, voffB); PG8_STAGE(PG8_SA(0, 0), a2, voffA);
            PG8_WAIT_V(8); PG8_WAIT_L(0); PG8_BAR; PG8_MMA(1, 0, At, B0); PG8_MMA(1, 1, At, B1); PG8_BAR; PG8_SCHED;
            PG8_LDB(B0, 1, 0); PG8_LDB(B1, 1, 1); PG8_SCHED; PG8_LDA(At, 1, 0); PG8_STAGE(PG8_SA(0, 1), a2 + hstep, voffA);
            PG8_WAIT_V(8); PG8_WAIT_L(0); PG8_BAR; PG8_MMA(0, 0, At, B0); PG8_MMA(0, 1, At, B1); PG8_BAR; PG8_SCHED;
            PG8_LDA(At, 1, 1); PG8_STAGE(PG8_SB(1, 0), b3, voffB); PG8_STAGE(PG8_SB(1, 1), b3 + hstep, voffB); PG8_STAGE(PG8_SA(1, 0), a3, voffA);
            PG8_WAIT_V(8); PG8_WAIT_L(0); PG8_BAR; PG8_MMA(1, 0, At, B0); PG8_MMA(1, 1, At, B1); PG8_BAR; PG8_SCHED;
            } else {
            PG8_LDB(B0, 0, 0); PG8_SCHED; PG8_LDA(At, 0, 0); PG8_STAGE(PG8_SA(1, 1), a1 + hstep, voffA);
            PG8_WAIT_L(8); PG8_BAR; PG8_WAIT_L(0); PG8_MMA(0, 0, At, B0); PG8_BAR; PG8_SCHED;
            PG8_LDB(B1, 0, 1); PG8_STAGE(PG8_SB(0, 0), b2, voffB);
            PG8_BAR; PG8_WAIT_L(0); PG8_MMA(0, 1, At, B1); PG8_BAR;
            PG8_LDA(At, 0, 1); PG8_STAGE(PG8_SA(0, 0), a2, voffA);
            PG8_BAR; PG8_WAIT_L(0); PG8_MMA(1, 0, At, B0); PG8_BAR; PG8_SCHED;
            PG8_STAGE(PG8_SB(0, 1), b2 + hstep, voffB);
            PG8_WAIT_V(6); PG8_BAR; PG8_MMA(1, 1, At, B1); PG8_BAR;
            PG8_LDB(B0, 1, 0); PG8_SCHED; PG8_LDA(At, 1, 0); PG8_STAGE(PG8_SA(0, 1), a2 + hstep, voffA);
            PG8_WAIT_L(8); PG8_BAR; PG8_WAIT_L(0); PG8_MMA(0, 0, At, B0); PG8_BAR; PG8_SCHED;
            PG8_LDB(B1, 1, 1); PG8_STAGE(PG8_SB(1, 0), b3, voffB);
            PG8_BAR; PG8_WAIT_L(0); PG8_MMA(0, 1, At, B1); PG8_BAR;
            PG8_LDA(At, 1, 1); PG8_STAGE(PG8_SA(1, 0), a3, voffA);
            PG8_BAR; PG8_WAIT_L(0); PG8_MMA(1, 0, At, B0); PG8_BAR; PG8_SCHED;
            PG8_STAGE(PG8_SB(1, 1), b3 + hstep, voffB);
            PG8_WAIT_V(6); PG8_BAR; PG8_MMA(1, 1, At, B1); PG8_BAR;
            }
        }
        if constexpr (ALIGN_EPI) { if (wr == 0) PG8_BAR; }
        if constexpr (!Epi::AFTER_DRAIN) { E(acc, cur, wr, wc, fr, fq); S.done(cur); }
        if (!has_next) break;
#pragma unroll
        for (int a = 0; a < 2; ++a)
#pragma unroll
            for (int b = 0; b < 2; ++b)
#pragma unroll
                for (int m = 0; m < 4; ++m)
#pragma unroll
                    for (int n = 0; n < 2; ++n) acc[a][b][m][n] = (f32x4){0.f, 0.f, 0.f, 0.f};
        cur = nxt; cA = nA; cB = nB; ++ui;
        if constexpr (ALIGN_EPI) { if (wr == 1) PG8_BAR; }
    }
    PG8_WAIT_V(0);
    if constexpr (!ALIGN_EPI) { if (wr == 0) PG8_BAR; }
    PG8_BAR;
    if constexpr (Epi::AFTER_DRAIN) { E.fused(acc, cur, wr, wc, fr, fq, lds, wid, lane); S.done(cur); }
#undef PG8_SA
#undef PG8_SB
#undef PG8_STAGE
#undef PG8_LDA
#undef PG8_LDB
#undef PG8_MMA
#undef PG8_WAIT_V
#undef PG8_WAIT_L
#undef PG8_BAR
#undef PG8_SCHED
}
}

#ifndef PG8_SP2
#define PG8_SP2 true
#endif
#ifndef PG8_ALIGN
#define PG8_ALIGN true
#endif
#include <hip/hip_bf16.h>
#include <cmath>
namespace attn_body {
using bf16=__hip_bfloat16;
using bf16x8=__attribute__((ext_vector_type(8)))short;
using s16x4=__attribute__((ext_vector_type(4)))short;
using f32x16=__attribute__((ext_vector_type(16)))float;
using u32x4=__attribute__((ext_vector_type(4)))unsigned;
constexpr int BATCH=2,NHEAD=16,SEQ=4096,D=64,DM=NHEAD*D,OP=2048;
constexpr int NW=8,QBLK=32,QB=QBLK*NW,KVBLK=64,NQB=SEQ/QB;
constexpr int ATTN_PITCH=DM, ATTN_UNIT_ROWS=QB;
__device__ __forceinline__ int crow(int r,int hi){return (r&3)+8*(r>>2)+4*hi;}
#define SBAR() __builtin_amdgcn_sched_barrier(0)
__device__ __forceinline__ void cmask(f32x16&p0,f32x16&p1,int jb,int qrel,int hi){
  const float NEG=-INFINITY; int kb=64*jb+4*hi;
  #pragma unroll
  for(int r=0;r<16;++r){int kv=kb+(r&3)+8*(r>>2); if(kv>qrel)p0[r]=NEG; if(kv+32>qrel)p1[r]=NEG;}
}

constexpr int NSLOT=3, SLOTB=8192;
constexpr int LDS_K=0, LDS_V=NSLOT*SLOTB, LDS_WS=2*NSLOT*SLOTB, LDS_OST=LDS_WS+NW*64*4, LDS_BYTES=LDS_OST+NW*4096;
constexpr float C2=0.125f*1.4426950408889634f;
__device__ __forceinline__ void glds16(const void*gsrc,unsigned lds_dst){unsigned keep;
  asm volatile("s_mov_b32 %0, m0\n\ts_mov_b32 m0, %2\n\ts_nop 0\n\tglobal_load_lds_dwordx4 %1, off\n\ts_mov_b32 m0, %0":"=&s"(keep):"v"(gsrc),"s"(lds_dst):"memory");}
__device__ __forceinline__ float max3f(float a,float b,float c){float r;asm("v_max3_f32 %0, %1, %2, %3":"=v"(r):"v"(a),"v"(b),"v"(c));return r;}
__device__ __forceinline__ float max2f(float a,float b){float r;asm("v_max_f32_e32 %0, %1, %2":"=v"(r):"v"(a),"v"(b));return r;}
__device__ __forceinline__ float fadd_s(float a,float b){float r;asm("v_add_f32_e32 %0, %1, %2":"=v"(r):"v"(a),"v"(b));return r;}
__device__ __forceinline__ float fsub_s(float a,float b){float r;asm("v_sub_f32_e32 %0, %1, %2":"=v"(r):"v"(a),"v"(b));return r;}
typedef float f32x2_t __attribute__((ext_vector_type(2))); typedef __bf16 bf16x2_t __attribute__((ext_vector_type(2)));
__device__ __forceinline__ unsigned cvtpk_s(float lo,float hi){f32x2_t v={lo,hi};bf16x2_t b=__builtin_convertvector(v,bf16x2_t);return __builtin_bit_cast(unsigned,b);}
#define WAIT_BAR(N) asm volatile("s_waitcnt vmcnt(" #N ") lgkmcnt(0)\n\ts_barrier":::"memory")

__device__ __forceinline__ void qkt(f32x16&p0,f32x16&p1,const char*Kslot,const bf16x8*qr,const f32x16&negm,int r32,int hi){
  const char*kb=Kslot+hi*1024+r32*16;
  #pragma unroll
  for(int d0=0;d0<4;++d0){
    const bf16x8 b0=*reinterpret_cast<const bf16x8*>(kb+d0*2048);
    const bf16x8 b1=*reinterpret_cast<const bf16x8*>(kb+d0*2048+512);
    if(d0==0){p0=__builtin_amdgcn_mfma_f32_32x32x16_bf16(b0,qr[0],negm,0,0,0);p1=__builtin_amdgcn_mfma_f32_32x32x16_bf16(b1,qr[0],negm,0,0,0);}
    else{p0=__builtin_amdgcn_mfma_f32_32x32x16_bf16(b0,qr[d0],p0,0,0,0);p1=__builtin_amdgcn_mfma_f32_32x32x16_bf16(b1,qr[d0],p1,0,0,0);}}
}
typedef __attribute__((address_space(3))) const char* lds_cptr;
typedef short v4i16_t __attribute__((ext_vector_type(4)));
__device__ __forceinline__ void kload8(bf16x8*kf,lds_cptr kp){
  kf[0]=*(const __attribute__((address_space(3))) bf16x8*)(kp);      kf[1]=*(const __attribute__((address_space(3))) bf16x8*)(kp+512);
  kf[2]=*(const __attribute__((address_space(3))) bf16x8*)(kp+2048); kf[3]=*(const __attribute__((address_space(3))) bf16x8*)(kp+2560);
  kf[4]=*(const __attribute__((address_space(3))) bf16x8*)(kp+4096); kf[5]=*(const __attribute__((address_space(3))) bf16x8*)(kp+4608);
  kf[6]=*(const __attribute__((address_space(3))) bf16x8*)(kp+6144); kf[7]=*(const __attribute__((address_space(3))) bf16x8*)(kp+6656);
}
__device__ __forceinline__ void kload2(bf16x8*kf,lds_cptr kp,int j){ kf[2*j]=*(const __attribute__((address_space(3))) bf16x8*)(kp+j*2048); kf[2*j+1]=*(const __attribute__((address_space(3))) bf16x8*)(kp+j*2048+512); }
__device__ __forceinline__ s16x4 vtr(lds_cptr p){ return __builtin_bit_cast(s16x4,__builtin_amdgcn_ds_read_tr16_b64_v4i16((__attribute__((address_space(3))) v4i16_t*)p)); }
__device__ __forceinline__ float rowmax(const f32x16&p0,const f32x16&p1){
  float a=max3f(p0[0],p0[1],p1[0]),b=max3f(p0[2],p0[3],p1[1]);a=max3f(a,p1[2],p1[3]);
  #pragma unroll
  for(int r=4;r<16;r+=4){a=max3f(a,p0[r],p0[r+1]);b=max3f(b,p0[r+2],p0[r+3]);a=max3f(a,p1[r],p1[r+1]);b=max3f(b,p1[r+2],p1[r+3]);}
  const float m=max2f(a,b);
  auto rr=__builtin_amdgcn_permlane32_swap(__float_as_uint(m),__float_as_uint(m),false,false);
  return max2f(__uint_as_float(rr[0]),__uint_as_float(rr[1]));
}
__device__ __forceinline__ void pv(f32x16*o,int vb,bf16x8 pa0,bf16x8 pa1,bf16x8 pa2,bf16x8 pa3){
  #pragma unroll
  for(int d0=0;d0<2;++d0){s16x4 lo[4],hi[4];
    #pragma unroll
    for(int ks=0;ks<4;++ks){
      asm volatile("ds_read_b64_tr_b16 %0,%1 offset:%c2":"=&v"(lo[ks]):"v"(vb),"i"(d0*4096+ks*1024):"memory");
      asm volatile("ds_read_b64_tr_b16 %0,%1 offset:%c2":"=&v"(hi[ks]):"v"(vb),"i"(d0*4096+ks*1024+512):"memory");}
    asm volatile("s_waitcnt lgkmcnt(0)":::"memory");SBAR();
    #define PK(k) (bf16x8){lo[k][0],lo[k][1],lo[k][2],lo[k][3],hi[k][0],hi[k][1],hi[k][2],hi[k][3]}
    o[d0]=__builtin_amdgcn_mfma_f32_32x32x16_bf16(pa0,PK(0),o[d0],0,0,0);
    o[d0]=__builtin_amdgcn_mfma_f32_32x32x16_bf16(pa1,PK(1),o[d0],0,0,0);
    o[d0]=__builtin_amdgcn_mfma_f32_32x32x16_bf16(pa2,PK(2),o[d0],0,0,0);
    o[d0]=__builtin_amdgcn_mfma_f32_32x32x16_bf16(pa3,PK(3),o[d0],0,0,0);
    #undef PK
  }
}

#ifndef ATTN_STORE16
#define ATTN_STORE16(p,v) (*(u32x4*)(p)=(v))
#endif
template<int THRL> __device__ __forceinline__ void attn_unit(int b,int h,int hv,int ocol,int qb,const bf16*Q,const bf16*__restrict__ K,const bf16*__restrict__ V,bf16*O,char*shm){
  const int tid=threadIdx.x,lane=tid&63,r32=lane&31,hi=lane>>5; const int wid=__builtin_amdgcn_readfirstlane(tid>>6);
  const long rowbase=(long)b*SEQ; const int q0=qb*QB;
  const bf16*Qw=Q+(rowbase+q0+wid*QBLK)*DM+h*D;
  const bf16*Kh=K+rowbase*DM+h*D,*Vh=V+rowbase*DM+hv*D;
  const unsigned lds0=(unsigned)(uintptr_t)shm;
  float*wsf=(float*)(shm+LDS_WS)+wid*64;
  const bf16*ksrc=Kh+(long)lane*DM+wid*8;
  const bf16*vsrc=Vh+(long)(16*(wid&3)+(lane>>2))*DM+(wid>>2)*32+(lane&3)*8;
  const unsigned kdst=lds0+LDS_K+wid*1024, vdst=lds0+LDS_V+wid*1024;
  #define DMA_K(t,slot) glds16(ksrc+(long)(t)*KVBLK*DM,(unsigned)__builtin_amdgcn_readfirstlane(kdst+(slot)))
  #define DMA_V(t,slot) glds16(vsrc+(long)(t)*KVBLK*DM,(unsigned)__builtin_amdgcn_readfirstlane(vdst+(slot)))
  const int vb0=(int)(lds0+LDS_V)+((lane>>4)&1)*32+(lane&3)*8+(4*hi+((lane&15)>>2))*64;
  const char*Kbase=shm+LDS_K; bf16x8 kf[8];
  const lds_cptr shm3=(lds_cptr)shm; const lds_cptr kp0=shm3+LDS_K+hi*1024+r32*16; const lds_cptr vp0=shm3+LDS_V+((lane>>4)&1)*32+(lane&3)*8+(4*hi+((lane&15)>>2))*64;
  const int NT=(q0+QB)/KVBLK;
  DMA_K(0,0);DMA_V(0,0);DMA_K(1,SLOTB);
  bf16x8 qr[4];
  #pragma unroll
  for(int d0=0;d0<4;++d0)qr[d0]=*reinterpret_cast<const bf16x8*>(&Qw[(long)r32*DM+d0*16+hi*8]);
  float mhat=0.f,l_reg=0.f;f32x16 o[2];o[0]=f32x16{};o[1]=f32x16{};f32x16 negm=f32x16{};asm volatile("":"+v"(negm));
  const int qrel=wid*QBLK+r32;
  #define CMASK(P0,P1,t) do{int jb_=(t)-(NT-4); if(jb_>=0)cmask(P0,P1,jb_,qrel,hi);}while(0)
  bool resc=false;
  #define START(P0,P1) do{ const float rm=rowmax(P0,P1); resc=false; \
    { const float dl=rm; mhat=fadd_s(mhat,dl); \
      _Pragma("unroll") for(int r=0;r<16;++r){P0[r]=fsub_s(P0[r],dl);P1[r]=fsub_s(P1[r],dl);} \
      _Pragma("unroll") for(int r=0;r<16;++r)negm[r]=-mhat; asm volatile("":"+v"(negm)); } \
    _Pragma("unroll") for(int r=0;r<16;++r)P0[r]=__builtin_amdgcn_exp2f(P0[r]); }while(0)
  #define RESC() do{ if(resc){ asm volatile("s_waitcnt lgkmcnt(0)":::"memory"); \
      _Pragma("unroll") for(int d_=0;d_<2;++d_) _Pragma("unroll") for(int r=0;r<16;++r)o[d_][r]*=wsf[crow(r,hi)]; } }while(0)
  f32x16 pA0,pA1,pB0,pB1;
  int sl_prev=0,sl_cur=0,sl_next=SLOTB;
  #define ROT() do{sl_prev=sl_cur;sl_cur=sl_next;sl_next=(sl_next==(NSLOT-1)*SLOTB)?0:sl_next+SLOTB;}while(0)
  DMA_K(2,2*SLOTB);
  WAIT_BAR(3);
  qkt(pA0,pA1,Kbase,qr,negm,r32,hi);asm volatile("s_nop 15\n\ts_nop 7":"+v"(pA0),"+v"(pA1));CMASK(pA0,pA1,0);
  START(pA0,pA1);
  _Pragma("unroll") for(int r=0;r<16;++r)pA1[r]=__builtin_amdgcn_exp2f(pA1[r]);
  WAIT_BAR(0);
  DMA_K(3,0);DMA_V(1,SLOTB);
  ROT();
  kload8(kf,kp0+sl_cur);
  WAIT_BAR(2);
  s16x4 vlo[8],vhi[8]; u32x4 pw0,pw1,pw2,pw3;
  #define PKW(P,B) cvtpk_s(P[B],P[B+1])
  #define PAF(k) __builtin_bit_cast(bf16x8,pw##k)
  #define VFR(i) (bf16x8){vlo[i][0],vlo[i][1],vlo[i][2],vlo[i][3],vhi[i][0],vhi[i][1],vhi[i][2],vhi[i][3]}
  #define PIN(x) asm volatile("":"+v"(x))
  #define MX3(a,b,c) __builtin_fmaxf(__builtin_fmaxf((a),(b)),(c))
  #define GAPA(MF,A0,A1,A2,A3,W0,W1,PW) do{ MF; sacc+=A0; sacc+=A1; sacc+=A2; sacc+=A3; PIN(sacc); W0; W1; PIN(PW); SBAR(); }while(0)
  #define EX(v) __builtin_amdgcn_exp2f(v)
  #define GAPB(MF,X,B) do{ MF; X[B]=EX(X[B]); X[B+1]=EX(X[B+1]); X[B+2]=EX(X[B+2]); X[B+3]=EX(X[B+3]); PIN(X); SBAR(); }while(0)
  #define VRD(i) do{ vlo[i]=vtr(vp_+(((i)>>2)*4096+((i)&3)*1024)); vhi[i]=vtr(vp_+(((i)>>2)*4096+((i)&3)*1024+512)); }while(0)
  #define KRD(G,j) do{ if(G){ kload2(kf,kp0+sl_next,j); SBAR(); } }while(0)
  #define STEP(C0,C1,P0,P1,t,GK,GV,GL) do{ SBAR(); \
    const lds_cptr vp_=vp0+sl_prev; \
    VRD(0); SBAR(); float sacc=(P0[0]+P0[1]); \
    GAPA(C0=__builtin_amdgcn_mfma_f32_32x32x16_bf16(kf[0],qr[0],negm,0,0,0), P0[2],P0[3],P0[4],P0[5],     pw0[0]=PKW(P0,0), pw0[1]=PKW(P0,2), pw0); \
    VRD(4); SBAR(); GAPA(C1=__builtin_amdgcn_mfma_f32_32x32x16_bf16(kf[1],qr[0],negm,0,0,0), P0[6],P0[7],P0[8],P0[9],     pw0[2]=PKW(P0,4), pw0[3]=PKW(P0,6), pw0); \
    VRD(1); SBAR(); GAPA(C0=__builtin_amdgcn_mfma_f32_32x32x16_bf16(kf[2],qr[1],C0,0,0,0),   P0[10],P0[11],P0[12],P0[13], pw1[0]=PKW(P0,8), pw1[1]=PKW(P0,10), pw1); \
    VRD(5); SBAR(); GAPA(C1=__builtin_amdgcn_mfma_f32_32x32x16_bf16(kf[3],qr[1],C1,0,0,0),   P0[14],P0[15],P1[0],P1[1],   pw1[2]=PKW(P0,12),pw1[3]=PKW(P0,14), pw1); \
    VRD(2); SBAR(); GAPA(C0=__builtin_amdgcn_mfma_f32_32x32x16_bf16(kf[4],qr[2],C0,0,0,0),   P1[2],P1[3],P1[4],P1[5],     pw2[0]=PKW(P1,0), pw2[1]=PKW(P1,2), pw2); \
    VRD(6); SBAR(); GAPA(C1=__builtin_amdgcn_mfma_f32_32x32x16_bf16(kf[5],qr[2],C1,0,0,0),   P1[6],P1[7],P1[8],P1[9],     pw2[2]=PKW(P1,4), pw2[3]=PKW(P1,6), pw2); \
    VRD(3); SBAR(); GAPA(C0=__builtin_amdgcn_mfma_f32_32x32x16_bf16(kf[6],qr[3],C0,0,0,0),   P1[10],P1[11],P1[12],P1[13], pw3[0]=PKW(P1,8), pw3[1]=PKW(P1,10), pw3); \
    VRD(7); SBAR(); GAPA(C1=__builtin_amdgcn_mfma_f32_32x32x16_bf16(kf[7],qr[3],C1,0,0,0),   P1[14],P1[15],0.f,0.f,       pw3[2]=PKW(P1,12),pw3[3]=PKW(P1,14), pw3); \
    l_reg+=sacc; \
    if(GK){DMA_K((t)+3,sl_cur);} if(GV){DMA_V((t)+1,sl_next);} \
    CMASK(C0,C1,t); \
    { float a=MX3(C0[0],C0[1],C1[0]),b=MX3(C0[2],C0[3],C1[1]); a=MX3(a,C1[2],C1[3]); \
      _Pragma("unroll") for(int r=4;r<16;r+=4){a=MX3(a,C0[r],C0[r+1]);b=MX3(b,C0[r+2],C0[r+3]);a=MX3(a,C1[r],C1[r+1]);b=MX3(b,C1[r+2],C1[r+3]);} \
      float rm=__builtin_fmaxf(a,b); { auto rr=__builtin_amdgcn_permlane32_swap(__float_as_uint(rm),__float_as_uint(rm),false,false); rm=__builtin_fmaxf(__uint_as_float(rr[0]),__uint_as_float(rr[1])); } \
      resc=false; \
      if(__builtin_expect(__any(rm>(float)THRL),0)){ const float dl=__builtin_fmaxf(rm,0.f); mhat+=dl; \
        _Pragma("unroll") for(int r=0;r<16;++r){C0[r]-=dl;C1[r]-=dl;} \
        _Pragma("unroll") for(int r=0;r<16;++r)negm[r]=-mhat; asm volatile("":"+v"(negm)); \
        const float f=__builtin_amdgcn_exp2f(-dl); l_reg*=f; if(hi==0)wsf[r32]=f; resc=true; } } \
    SBAR(); \
    GAPB(o[0]=__builtin_amdgcn_mfma_f32_32x32x16_bf16(PAF(0),VFR(0),o[0],0,0,0), C0,0); \
    GAPB(o[1]=__builtin_amdgcn_mfma_f32_32x32x16_bf16(PAF(0),VFR(4),o[1],0,0,0), C0,4); \
    KRD(GL,0); GAPB(o[0]=__builtin_amdgcn_mfma_f32_32x32x16_bf16(PAF(1),VFR(1),o[0],0,0,0), C0,8); \
    KRD(GL,1); GAPB(o[1]=__builtin_amdgcn_mfma_f32_32x32x16_bf16(PAF(1),VFR(5),o[1],0,0,0), C0,12); \
    KRD(GL,2); GAPB(o[0]=__builtin_amdgcn_mfma_f32_32x32x16_bf16(PAF(2),VFR(2),o[0],0,0,0), C1,0); \
    KRD(GL,3); GAPB(o[1]=__builtin_amdgcn_mfma_f32_32x32x16_bf16(PAF(2),VFR(6),o[1],0,0,0), C1,4); \
    GAPB(o[0]=__builtin_amdgcn_mfma_f32_32x32x16_bf16(PAF(3),VFR(3),o[0],0,0,0), C1,8); \
    GAPB(o[1]=__builtin_amdgcn_mfma_f32_32x32x16_bf16(PAF(3),VFR(7),o[1],0,0,0), C1,12); \
    }while(0)
  int t=1;
  #undef CMASK
  #define CMASK(P0,P1,t) do{}while(0)
  for(;t+5<NT;t+=2){
    STEP(pB0,pB1,pA0,pA1,t,true,true,true);     WAIT_BAR(2); RESC(); ROT();
    STEP(pA0,pA1,pB0,pB1,t+1,true,true,true);   WAIT_BAR(2); RESC(); ROT();
  }
  #undef CMASK
  #define CMASK(P0,P1,t) do{int jb_=(t)-(NT-4); if(jb_>=0)cmask(P0,P1,jb_,qrel,hi);}while(0)
  #define ENDW(tt) do{ if((tt)+3<NT){WAIT_BAR(2);} else if((tt)+2<NT){WAIT_BAR(1);} else {WAIT_BAR(0);} }while(0)
  for(;t+1<NT;t+=2){
    STEP(pB0,pB1,pA0,pA1,t,(t+3<NT),(t+1<NT),(t+1<NT));       ENDW(t);   RESC(); ROT();
    STEP(pA0,pA1,pB0,pB1,t+1,(t+4<NT),(t+2<NT),(t+2<NT));     ENDW(t+1); RESC(); ROT();
  }
  STEP(pB0,pB1,pA0,pA1,NT-1,false,false,false); RESC();
  { float sacc=pB0[0]+pB0[1]; _Pragma("unroll") for(int r=2;r<16;++r)sacc+=pB0[r]; _Pragma("unroll") for(int r=0;r<16;++r)sacc+=pB1[r]; l_reg+=sacc;
    pw0=(u32x4){PKW(pB0,0),PKW(pB0,2),PKW(pB0,4),PKW(pB0,6)};pw1=(u32x4){PKW(pB0,8),PKW(pB0,10),PKW(pB0,12),PKW(pB0,14)};pw2=(u32x4){PKW(pB1,0),PKW(pB1,2),PKW(pB1,4),PKW(pB1,6)};pw3=(u32x4){PKW(pB1,8),PKW(pB1,10),PKW(pB1,12),PKW(pB1,14)};
    SBAR(); pv(o,vb0+sl_cur,PAF(0),PAF(1),PAF(2),PAF(3)); }
  #undef PKW
  #undef PAF
  #undef VFR
  #undef PIN
  #undef MX3
  #undef GAPA
  #undef GAPB
  #undef EX
  #undef VRD
  #undef KRD
  #undef STEP
  #undef ENDW
  {auto rr=__builtin_amdgcn_permlane32_swap(__float_as_uint(l_reg),__float_as_uint(l_reg),false,false);l_reg=__uint_as_float(rr[0])+__uint_as_float(rr[1]);}
  if(hi==0)wsf[32+r32]=l_reg;asm volatile("s_waitcnt lgkmcnt(0)":::"memory");
  float rli[16];
  #pragma unroll
  for(int r=0;r<16;++r)rli[r]=__builtin_amdgcn_rcpf(wsf[32+crow(r,hi)]);
  bf16*Ow=O+(rowbase+q0+wid*QBLK)*OP+ocol;
  { bf16*stg=(bf16*)(shm+LDS_OST)+wid*2048;
    #pragma unroll
    for(int r=0;r<16;++r){const int orow=crow(r,hi);
      #pragma unroll
      for(int d0=0;d0<2;++d0)stg[orow*64+d0*32+r32]=__float2bfloat16(o[d0][r]*rli[r]);}
    asm volatile("s_waitcnt lgkmcnt(0)":::"memory");
    #pragma unroll
    for(int i=0;i<4;++i){const int row=i*8+(lane>>3),ch=lane&7; const u32x4 v=*(const u32x4*)(stg+row*64+ch*8); ATTN_STORE16(Ow+(long)row*OP+ch*8,v);} }
  asm volatile("s_waitcnt lgkmcnt(0)\n\ts_barrier":::"memory");
  #undef DMA_K
  #undef DMA_V
  #undef CMASK
  #undef START
  #undef RESC
  #undef ROT
}
constexpr int ATTN_LDS_BYTES=LDS_BYTES;
struct AttnTensors { const bf16* Q; const bf16* K; const bf16* V; bf16* O; };
struct AttnUnit { int combo; int qb; };
struct StaticOrder {
  int vcu;
  __device__ __forceinline__ explicit StaticOrder(int vcu_):vcu(vcu_){}
  __device__ __forceinline__ bool next(int i,AttnUnit&u)const{ if(i>=4||vcu>=256)return false; const int s=vcu&3; u.combo=vcu>>2; u.qb=(i==0)?s:(i==1)?7-s:(i==2)?8+s:15-s; return true; }
};
template<class Sched,int THRL=8> __device__ __forceinline__ void attn_phase(char*lds,const AttnTensors&T,const Sched&S){
  AttnUnit u;
  for(int i=0;S.next(i,u);++i){ const int vh=u.combo&1, mp=(u.combo>>1)&1, h=(u.combo>>2)&7, b=u.combo>>5;
    attn_unit<THRL>(b,2*h+mp,2*h+vh,h*256+mp*128+vh*64,u.qb,T.Q,T.K,T.V,T.O,lds); }
}
#undef SBAR
#undef WAIT_BAR
}

constexpr int NWAVES = 8;
#ifndef MK_N_LAUNCHES
#define MK_N_LAUNCHES 1
#endif
constexpr int N_PHASES = 10;
constexpr int N_LAUNCHES = MK_N_LAUNCHES;
static_assert(N_LAUNCHES == 1 || N_LAUNCHES == N_PHASES, "MK_N_LAUNCHES is 1 or N_PHASES");

constexpr int DMODEL = 2048, SEQ = 4096, NBATCH = 2, MPR = NBATCH * SEQ, DBATCH = 8, DSEQ = 8, MSM = DBATCH * DSEQ, MREAL = MPR + MSM, MPAD = 8448;
constexpr int DIN = 5120, DFF = 5632, DUP = 2 * DFF, NH = 8, HD = 128;
constexpr int NPG = 128, PAGE = 128;
constexpr int NSPLIT = 32, PPS = NPG / NSPLIT;
constexpr float EPS = 1e-6f, LAM_INIT = 0.2f, SUBLN_SCALE = 1.0f - LAM_INIT;
constexpr float C2 = 0.125f * 1.4426950408889634f;

constexpr size_t OUT_YP = 0, OUT_YS = OUT_YP + (size_t)MPR * DMODEL, OUT_KP = OUT_YS + (size_t)MSM * DMODEL, OUT_VP = OUT_KP + (size_t)MPR * 1024,
                 OUT_CP = OUT_VP + (size_t)MPR * 1024, OUT_KS = OUT_CP + (size_t)NBATCH * 2 * DUP, OUT_VS = OUT_KS + (size_t)MSM * 1024,
                 OUT_CS = OUT_VS + (size_t)MSM * 1024, OUT_GV = OUT_CS + (size_t)DBATCH * 2 * DUP, OUT_END = OUT_GV + (size_t)MSM * 1024;

constexpr size_t MiB = 1u << 20;
constexpr size_t al(size_t x) { return (x + MiB - 1) / MiB * MiB; }
constexpr size_t WS_CTL = 0, CTL_ZERO_BYTES = MiB;
constexpr size_t WS_WIN = MiB;
constexpr size_t WS_WOUT = WS_WIN + al((size_t)DIN * DMODEL * 2);
constexpr size_t WS_WUP = WS_WOUT + al((size_t)DMODEL * DMODEL * 2);
constexpr size_t WS_WDN = WS_WUP + al((size_t)DUP * DMODEL * 2);
constexpr size_t WS_XN = WS_WDN + al((size_t)DMODEL * DFF * 2);
constexpr size_t ACT1 = al((size_t)MPAD * 1024 * 2);
constexpr size_t WS_U = WS_XN + al((size_t)MPAD * DMODEL * 2);
constexpr size_t WS_VA = WS_U + ACT1, WS_Q = WS_VA + ACT1, WS_K = WS_Q + ACT1, WS_V = WS_K + ACT1;
constexpr size_t WS_O4 = WS_V + ACT1;
constexpr size_t WS_MIXIN = WS_O4 + al((size_t)MPAD * 2048 * 2);
constexpr size_t WS_MIX = WS_MIXIN + al((size_t)MPAD * 2048 * 2);
constexpr size_t WS_H = WS_MIX + al((size_t)MPAD * 2048 * 4);
constexpr size_t WS_HN = WS_H + al((size_t)MPAD * 2048 * 4);
constexpr size_t WS_UP = WS_HN + al((size_t)MPAD * 2048 * 2);
constexpr size_t WS_G = WS_UP + al((size_t)MPAD * DUP * 2);
constexpr size_t WS_Y = WS_G + al((size_t)MPAD * DFF * 2);
constexpr size_t WS_DPART = WS_Y + al((size_t)MPAD * 2048 * 4);
constexpr size_t WS_DML = WS_DPART + al((size_t)DBATCH * NH * NSPLIT * 16 * 128 * 4);
constexpr size_t WS_PARTM = WS_DML + MiB;
constexpr size_t WS_PARTY = WS_PARTM + al((size_t)16 * 64 * 2048 * 4);
constexpr size_t WS_END = WS_PARTY + al((size_t)22 * 64 * 2048 * 4);
constexpr int KS_MIX = 16, KL_MIX = DMODEL / KS_MIX, KS_Y = 22, KL_Y = DFF / KS_Y;
constexpr int CW_TMO = 0, CW_Q2 = 1024, CW_BAR = 4096;

constexpr int RING_OFF = 0, RING_BYTES = 131072;
constexpr int LDSCTL_OFF = RING_BYTES, MISC_OFF = LDSCTL_OFF + 320;
constexpr int LDS_BYTES = 147456;
static_assert(MISC_OFF + 128 <= LDS_BYTES, "LDS map");
#define GAS __attribute__((address_space(1)))
#define LAS __attribute__((address_space(3)))
typedef unsigned short bf16;
typedef unsigned v4u __attribute__((ext_vector_type(4)));
typedef float f32x4 __attribute__((ext_vector_type(4)));
typedef short bf16x8 __attribute__((ext_vector_type(8)));
typedef GAS unsigned gu32;
typedef GAS unsigned long long gu64;
#define RLX_AGENT __ATOMIC_RELAXED, __HIP_MEMORY_SCOPE_AGENT
#define LDS_WAIT() asm volatile("s_waitcnt lgkmcnt(0)" ::: "memory")
#define VM_WAIT() asm volatile("s_waitcnt vmcnt(0)" ::: "memory")
__device__ __forceinline__ unsigned long long rt() { return __builtin_amdgcn_s_memrealtime(); }
__device__ __forceinline__ unsigned f2bf(float f) { unsigned u = __builtin_bit_cast(unsigned, f); return (u + 0x7fffu + ((u >> 16) & 1u)) >> 16; }
__device__ __forceinline__ unsigned pk2(float lo, float hi) { return f2bf(lo) | (f2bf(hi) << 16); }

#define XB_TMO      128
#define XB_XCNT(j)  (256  + 64 * (j))
#define XB_XSUB(j)  (1280 + 64 * (j))
#define XB_XGEN(j)  (2304 + 64 * (j))
#define XB_TOP      3328
#define XB_TOPGEN   3392
#define XCD_BAR_WORDS 3456
#define XB_SPIN_CAP (1u << 18)

__device__ __forceinline__ unsigned xb_ld(unsigned* p)              { return __hip_atomic_load(p, __ATOMIC_RELAXED, __HIP_MEMORY_SCOPE_AGENT); }
__device__ __forceinline__ unsigned xb_add(unsigned* p, unsigned v) { return __hip_atomic_fetch_add(p, v, __ATOMIC_RELAXED, __HIP_MEMORY_SCOPE_AGENT); }
__device__ __forceinline__ unsigned xb_xcc_id() { return (unsigned)__builtin_amdgcn_s_getreg((3 << 11) | 20) & 0xFu; }
#define XB_SPIN(cond, bar) do { unsigned _sp = 0; while (cond) { __builtin_amdgcn_s_sleep(1); \
    if ((++_sp & 255u) == 0u) { if (xb_ld(&(bar)[XB_TMO])) break; if (_sp > XB_SPIN_CAP) { atomicAdd(&(bar)[XB_TMO], 1u); break; } } } } while (0)

struct XcdBarrier {
    unsigned* bar; unsigned x;
    volatile LAS unsigned* st;
};

__device__ __forceinline__ XcdBarrier xcd_barrier_post(unsigned* bar, volatile LAS unsigned* st) {
    XcdBarrier b; b.bar = bar; b.x = xb_xcc_id(); b.st = st;
    if (threadIdx.x == 0) (void)xb_add(&bar[XB_XCNT(b.x)], 1u);
    return b;
}
__device__ __forceinline__ void xcd_barrier_complete(unsigned* bar, unsigned x, unsigned& nloc, unsigned& nx) {
    const unsigned G = gridDim.x * gridDim.y * gridDim.z;
    unsigned sum, cnt, mine, sp = 0u;
    for (;;) {
        sum = 0u; cnt = 0u; mine = 0u;
#pragma unroll
        for (unsigned j = 0; j < 16; ++j) { const unsigned c = xb_ld(&bar[XB_XCNT(j)]); sum += c; cnt += (c > 0u) ? 1u : 0u; mine = (j == x) ? c : mine; }
        if (sum == G) break;
        __builtin_amdgcn_s_sleep(1);
        if ((++sp & 255u) == 0u) { if (xb_ld(&bar[XB_TMO])) break; if (sp > XB_SPIN_CAP) { atomicAdd(&bar[XB_TMO], 1u); break; } }
    }
    nloc = mine > 0u ? mine : 1u; nx = cnt > 0u ? cnt : 1u;
}

__device__ __forceinline__ void xcd_barrier(const XcdBarrier& b) {
    asm volatile("s_waitcnt vmcnt(0)" ::: "memory");
    __syncthreads();
    if (threadIdx.x == 0) {
        unsigned* bar = b.bar;
        __builtin_amdgcn_s_waitcnt(0);
        unsigned nloc = b.st[0], nx = b.st[1];
        if (nloc == 0u) { xcd_barrier_complete(bar, b.x, nloc, nx); b.st[0] = nloc; b.st[1] = nx; }
        const unsigned old = xb_add(&bar[XB_XSUB(b.x)], 1u);
        const unsigned gen = old / nloc;
        if (old + 1u == (gen + 1u) * nloc) {
            __builtin_amdgcn_fence(__ATOMIC_RELEASE, "agent");
            asm volatile("s_waitcnt vmcnt(0)" ::: "memory");
            const unsigned og = xb_add(&bar[XB_TOP], 1u);
            const unsigned tg = og / nx;
            if (og + 1u == (tg + 1u) * nx) xb_add(&bar[XB_TOPGEN], 1u);
            else XB_SPIN(xb_ld(&bar[XB_TOPGEN]) == tg, bar);
            __builtin_amdgcn_fence(__ATOMIC_ACQUIRE, "agent");
            xb_add(&bar[XB_XGEN(b.x)], 1u);
            asm volatile("s_waitcnt vmcnt(0)" ::: "memory");
        } else {
            XB_SPIN(xb_ld(&bar[XB_XGEN(b.x)]) == gen, bar);
            __builtin_amdgcn_fence(__ATOMIC_ACQUIRE, "agent");
            asm volatile("s_waitcnt vmcnt(0)" ::: "memory");
        }
    }
    __syncthreads();
}

typedef unsigned short v4us __attribute__((ext_vector_type(4)));
typedef float f32x2 __attribute__((ext_vector_type(2)));
typedef short s16x4 __attribute__((ext_vector_type(4)));
struct Frame {
    LAS unsigned char* lds;
    volatile LAS unsigned* MISC;
    gu32* ctl;
    int tid, lane, wave, vcu, G;
    const float *x_prompt, *x_sample, *cache_k, *cache_v, *state_conv; const int* page_table;
    const float *g_pre_mix, *w_in, *g_v_a, *w_s, *b_s, *lq1, *lk1, *lq2, *lk2, *g_subln, *w_out, *g_post_mix, *g_pre_ffn, *w_up, *w_conv, *b_conv, *w_down, *g_post_ffn;
    float* out;
    bf16 *Win_t, *Wout_t, *Wup_t, *Wdn_t, *XN, *U, *VA, *Q, *K, *V, *O4, *MIXIN, *HN, *UP, *GB;
    float *MIX, *H, *Y, *DPART, *DML, *PARTM, *PARTY;
};
__device__ __forceinline__ float wave_sum(float v) {
#pragma unroll
    for (int o = 1; o < 64; o <<= 1) v += __shfl_xor(v, o);
    return v;
}
__device__ __forceinline__ float wave_max(float v) {
#pragma unroll
    for (int o = 1; o < 64; o <<= 1) v = fmaxf(v, __shfl_xor(v, o));
    return v;
}
__device__ __forceinline__ float bf2f(unsigned short b) { return __uint_as_float((unsigned)b << 16); }
__device__ __forceinline__ float bflo(unsigned w) { return __uint_as_float(w << 16); }
__device__ __forceinline__ float bfhi(unsigned w) { return __uint_as_float(w & 0xffff0000u); }
__device__ __forceinline__ float gelu_f(float x) { return pg8::gelu_t(x); }
__device__ __forceinline__ float lam_of(const Frame& F) {
    float a = F.lq1[F.lane] * F.lk1[F.lane], b = F.lq2[F.lane] * F.lk2[F.lane];
    a = wave_sum(a); b = wave_sum(b);
    return __expf(a) - __expf(b) + LAM_INIT;
}

__device__ __forceinline__ void p0_transpose_item(const float* W, int K, int N, bf16* WT, LAS float* scr, int item, int lane) {
    const int nblk = N / 32, kb = item / nblk, nb = item % nblk, k0 = 64 * kb, n0 = 32 * nb;
#pragma unroll 8
    for (int i = 0; i < 32; ++i) { const int kk = 2 * i + (lane >> 5); scr[kk * 33 + (lane & 31)] = W[(size_t)(k0 + kk) * N + n0 + (lane & 31)]; }
    LDS_WAIT(); asm volatile("" ::: "memory");
    const int c = lane & 7;
#pragma unroll
    for (int j = 0; j < 4; ++j) { const int n = (lane >> 3) + 8 * j; const LAS float* s = scr + (8 * c) * 33 + n;
        v4u o; o.x = pk2(s[0 * 33], s[1 * 33]); o.y = pk2(s[2 * 33], s[3 * 33]); o.z = pk2(s[4 * 33], s[5 * 33]); o.w = pk2(s[6 * 33], s[7 * 33]);
        *(GAS v4u*)(WT + (size_t)(n0 + n) * K + k0 + 8 * c) = o; }
    LDS_WAIT(); asm volatile("" ::: "memory");
}
__device__ __forceinline__ void rms_row_to_bf16(const Frame& F, const float* xrow, const float* gain, bf16* orow) {
    const GAS f32x4* xr = (const GAS f32x4*)xrow + F.lane; const GAS f32x4* gr = (const GAS f32x4*)gain + F.lane;
    f32x4 v[8]; float s = 0.f;
#pragma unroll
    for (int j = 0; j < 8; ++j) { v[j] = xr[64 * j]; s += (v[j].x * v[j].x + v[j].y * v[j].y) + (v[j].z * v[j].z + v[j].w * v[j].w); }
    const float r = 1.0f / sqrtf(wave_sum(s) * (1.f / DMODEL) + EPS);
    GAS unsigned long long* o8 = (GAS unsigned long long*)orow + F.lane;
#pragma unroll
    for (int j = 0; j < 8; ++j) { const f32x4 g = gr[64 * j]; const f32x4 y = v[j] * r * g;
        o8[64 * j] = (unsigned long long)pk2(y.x, y.y) | ((unsigned long long)pk2(y.z, y.w) << 32); }
}
__device__ __forceinline__ void p0_prologue(const Frame& F) {
    LAS float* scr = (LAS float*)(F.lds + RING_OFF + F.wave * 16384);
    const int gw = F.vcu * NWAVES + F.wave, NGW = F.G * NWAVES;
    constexpr int I_IN = (DMODEL / 64) * (DIN / 32), I_OUT = (DMODEL / 64) * (DMODEL / 32), I_UP = (DMODEL / 64) * (DUP / 32), I_DN = (DFF / 64) * (DMODEL / 32);
    constexpr int NITEMS = I_IN + I_OUT + I_UP + I_DN;
    for (int it = gw; it < NITEMS; it += NGW) {
        int r = it;
        if (r < I_IN) { p0_transpose_item(F.w_in, DMODEL, DIN, F.Win_t, scr, r, F.lane); continue; } r -= I_IN;
        if (r < I_OUT) { p0_transpose_item(F.w_out, DMODEL, DMODEL, F.Wout_t, scr, r, F.lane); continue; } r -= I_OUT;
        if (r < I_UP) { p0_transpose_item(F.w_up, DMODEL, DUP, F.Wup_t, scr, r, F.lane); continue; } r -= I_UP;
        p0_transpose_item(F.w_down, DFF, DMODEL, F.Wdn_t, scr, r, F.lane);
    }
    for (int m = gw; m < MREAL; m += NGW) {
        const float* xr = m < MPR ? F.x_prompt + (size_t)m * DMODEL : F.x_sample + (size_t)(m - MPR) * DMODEL;
        rms_row_to_bf16(F, xr, F.g_pre_mix, F.XN + (size_t)m * DMODEL);
    }
}

constexpr int VPITCH = 288;
constexpr int DEC_VBUF = 32 * VPITCH;
__device__ __forceinline__ bf16x8 cvt8(f32x4 a, f32x4 b) { v4u w; w.x = pg8::cvt_pk_bf16(a[0], a[1]); w.y = pg8::cvt_pk_bf16(a[2], a[3]); w.z = pg8::cvt_pk_bf16(b[0], b[1]); w.w = pg8::cvt_pk_bf16(b[2], b[3]); return __builtin_bit_cast(bf16x8, w); }
__device__ __forceinline__ s16x4 tr16(LAS const unsigned char* p) { return __builtin_bit_cast(s16x4, __builtin_amdgcn_ds_read_tr16_b64_v4i16((LAS s16x4*)p)); }
__device__ __forceinline__ bf16x8 cat8(s16x4 lo, s16x4 hi) { return (bf16x8){lo[0], lo[1], lo[2], lo[3], hi[0], hi[1], hi[2], hi[3]}; }

#define DEC_ISSUE_K(buf, Kp_, pb_) do { _Pragma("unroll") for (int kb2 = 0; kb2 < 2; ++kb2) { const float* kr_ = (Kp_) + (16 * (2 * (pb_) + kb2)) * 1024;     \
        _Pragma("unroll") for (int s = 0; s < 4; ++s) { buf[kb2 * 8 + 2 * s] = *(const f32x4*)(kr_ + (voffK + 32 * s)); buf[kb2 * 8 + 2 * s + 1] = *(const f32x4*)(kr_ + (voffK + 32 * s + 16)); } } } while (0)
#define DEC_ISSUE_V(buf, Vp_, u_) do { _Pragma("unroll") for (int i = 0; i < 16; ++i) { const float* vr_ = (Vp_) + (32 * (u_) + 2 * i) * 1024; buf[i] = *(const f32x4*)(vr_ + voffV); } } while (0)
#define DEC_USE_K(buf, pb_) do { _Pragma("unroll") for (int kb2 = 0; kb2 < 2; ++kb2) { f32x4 acc_ = (f32x4){0.f, 0.f, 0.f, 0.f}; \
        _Pragma("unroll") for (int s = 0; s < 4; ++s) acc_ = __builtin_amdgcn_mfma_f32_16x16x32_bf16(cvt8(buf[kb2 * 8 + 2 * s], buf[kb2 * 8 + 2 * s + 1]), *(const LAS bf16x8*)(qlds + s * 1024), acc_, 0, 0, 0); \
        st[2 * (pb_) + kb2] = acc_; } asm volatile("" ::: "memory"); } while (0)
#define DEC_USE_V(buf, u_) do { _Pragma("unroll") for (int i = 0; i < 16; ++i) { f32x2 pk_; pk_.x = __uint_as_float(pg8::cvt_pk_bf16(buf[i][0], buf[i][1])); pk_.y = __uint_as_float(pg8::cvt_pk_bf16(buf[i][2], buf[i][3])); \
            *(LAS f32x2*)(vbuf + (2 * i + (lane >> 5)) * VPITCH + (lane & 31) * 8) = pk_; } \
        asm volatile("s_waitcnt lgkmcnt(0)" ::: "memory"); \
        _Pragma("unroll") for (int n = 0; n < 8; ++n) { const s16x4 lo_ = tr16(trb + n * 32), hi_ = tr16(trb + 16 * VPITCH + n * 32); \
            o[n] = __builtin_amdgcn_mfma_f32_16x16x32_bf16(pa[u_], cat8(lo_, hi_), o[n], 0, 0, 0); } \
        asm volatile("s_waitcnt lgkmcnt(0)" ::: "memory"); } while (0)
__device__ __forceinline__ void decode_unit(const Frame& F, int b, int sp) {
    int lane = F.lane; asm volatile("" : "+v"(lane));
    const int w = F.wave, r = lane & 15, g = lane >> 4;
    LAS unsigned char* vbuf = F.lds + RING_OFF + w * DEC_VBUF;
    LAS unsigned char* qlds = F.lds + RING_OFF + NWAVES * DEC_VBUF + w * 4096 + lane * 16;
    {
        const bf16* qrow = F.Q + (size_t)(MPR + b * DSEQ + (r & 7)) * 1024 + w * HD + 4 * g;
#pragma unroll
        for (int s = 0; s < 4; ++s) {
            const bool live = (r < 8) ? (s < 2) : (s >= 2);
            unsigned long long lo = 0ull, hi = 0ull;
            if (live) { lo = *(const unsigned long long*)(qrow + 32 * s); hi = *(const unsigned long long*)(qrow + 32 * s + 16); }
            v4u t; t.x = (unsigned)lo; t.y = (unsigned)(lo >> 32); t.z = (unsigned)hi; t.w = (unsigned)(hi >> 32);
            *(LAS v4u*)(qlds + s * 1024) = t;
        }
        asm volatile("s_waitcnt lgkmcnt(0)" ::: "memory");
    }
    float m_run = -INFINITY, l_run = 0.f;
    f32x4 o[8];
#pragma unroll
    for (int n = 0; n < 8; ++n) o[n] = (f32x4){0.f, 0.f, 0.f, 0.f};
    const int li = lane & 15, tq = li >> 2, tp = li & 3;
    LAS const unsigned char* trb = vbuf + (4 * g + tq) * VPITCH + tp * 8;
    f32x4 bufA[16], bufB[16];
    const unsigned voffK = (unsigned)(r * 1024 + 4 * g), voffV = (unsigned)((lane >> 5) * 1024 + 4 * (lane & 31));
    const int* pt = F.page_table + b * NPG + sp * PPS;
    int phys = pt[0];
    const float* Kp = F.cache_k + ((size_t)phys * PAGE) * 1024 + w * HD;
    DEC_ISSUE_K(bufA, Kp, 0);
    for (int pi = 0; pi < PPS; ++pi) {
        const float* Vp = F.cache_v + ((size_t)phys * PAGE) * 1024 + w * HD;
        const int physn = pt[pi + 1 < PPS ? pi + 1 : pi];
        const float* Kn = F.cache_k + ((size_t)physn * PAGE) * 1024 + w * HD;
        f32x4 st[8];
        DEC_ISSUE_K(bufB, Kp, 1); DEC_USE_K(bufA, 0);
        DEC_ISSUE_K(bufA, Kp, 2); DEC_USE_K(bufB, 1);
        DEC_ISSUE_K(bufB, Kp, 3); DEC_USE_K(bufA, 2);
        DEC_ISSUE_V(bufA, Vp, 0); DEC_USE_K(bufB, 3);
        float mx = -INFINITY;
#pragma unroll
        for (int kb = 0; kb < 8; ++kb) mx = fmaxf(mx, fmaxf(fmaxf(st[kb][0], st[kb][1]), fmaxf(st[kb][2], st[kb][3])));
        mx = fmaxf(mx, __shfl_xor(mx, 16)); mx = fmaxf(mx, __shfl_xor(mx, 32));
        const float m_new = fmaxf(m_run, mx);
        const float fsc = __builtin_amdgcn_exp2f(m_run - m_new);
        float rs = 0.f;
#pragma unroll
        for (int kb = 0; kb < 8; ++kb) {
#pragma unroll
            for (int e = 0; e < 4; ++e) { const float p = __builtin_amdgcn_exp2f(st[kb][e] - m_new); st[kb][e] = p; rs += p; }
        }
        rs += __shfl_xor(rs, 16); rs += __shfl_xor(rs, 32);
        l_run = l_run * fsc + rs; m_run = m_new;
        float f4[4];
#pragma unroll
        for (int e = 0; e < 4; ++e) f4[e] = __shfl(fsc, 4 * g + e);
#pragma unroll
        for (int n = 0; n < 8; ++n) { o[n][0] *= f4[0]; o[n][1] *= f4[1]; o[n][2] *= f4[2]; o[n][3] *= f4[3]; }
        bf16x8 pa[4];
#pragma unroll
        for (int u = 0; u < 4; ++u) pa[u] = cvt8(st[2 * u], st[2 * u + 1]);
        DEC_ISSUE_V(bufB, Vp, 1); DEC_USE_V(bufA, 0);
        DEC_ISSUE_V(bufA, Vp, 2); DEC_USE_V(bufB, 1);
        DEC_ISSUE_V(bufB, Vp, 3); DEC_USE_V(bufA, 2);
        if (pi + 1 < PPS) DEC_ISSUE_K(bufA, Kn, 0);
        DEC_USE_V(bufB, 3);
        phys = physn; Kp = Kn;
    }
    const size_t pbase = ((size_t)(b * NH + w) * NSPLIT + sp) * 16;
    if (g == 0) { *(f32x2*)(F.DML + (pbase + r) * 2) = (f32x2){m_run, l_run}; }
#pragma unroll
    for (int n = 0; n < 8; ++n)
#pragma unroll
        for (int e = 0; e < 4; ++e) F.DPART[(pbase + 4 * g + e) * 128 + 16 * n + r] = o[n][e];
}

__device__ __forceinline__ void gmlp_unit(const Frame& F, int unit) {
    int tid = F.tid; asm volatile("" : "+v"(tid));
    const int lane = tid & 63, w = F.wave, r = lane & 15, g = lane >> 4;
    int b, h, row0, nvalid; bool samp = unit >= 512;
    if (!samp) { b = unit >> 8; const int c = (unit >> 3) & 31; h = unit & 7; row0 = b * SEQ + c * 128; nvalid = 128; }
    else { const int su = unit - 512; b = su >> 3; h = su & 7; row0 = MPR + b * DSEQ; nvalid = DSEQ; }
    LAS unsigned char* tile = F.lds + RING_OFF;
    {
        const int s = tid >> 2, part = tid & 3;
        v4u raw[4]; float vals[32]; float ss = 0.f;
        if (s < nvalid) {
            const bf16* src = F.VA + (size_t)(row0 + s) * 1024 + h * HD + part * 32;
#pragma unroll
            for (int i = 0; i < 4; ++i) raw[i] = *(const v4u*)(src + 8 * i);
        } else {
#pragma unroll
            for (int i = 0; i < 4; ++i) raw[i] = (v4u){0u, 0u, 0u, 0u};
        }
#pragma unroll
        for (int i = 0; i < 4; ++i) {
            vals[8 * i + 0] = bflo(raw[i].x); vals[8 * i + 1] = bfhi(raw[i].x); vals[8 * i + 2] = bflo(raw[i].y); vals[8 * i + 3] = bfhi(raw[i].y);
            vals[8 * i + 4] = bflo(raw[i].z); vals[8 * i + 5] = bfhi(raw[i].z); vals[8 * i + 6] = bflo(raw[i].w); vals[8 * i + 7] = bfhi(raw[i].w);
        }
#pragma unroll
        for (int i = 0; i < 32; ++i) ss += vals[i] * vals[i];
        ss += __shfl_xor(ss, 1); ss += __shfl_xor(ss, 2);
        const float rstd = 1.0f / sqrtf(ss * (1.0f / HD) + EPS);
        const float* gv = F.g_v_a + h * HD + part * 32;
#pragma unroll
        for (int i = 0; i < 32; ++i) vals[i] = vals[i] * rstd * gv[i];
        if (samp && s < nvalid) {
            float* go = F.out + OUT_GV + ((size_t)((b * DSEQ + s) * NH + h)) * HD + part * 32;
#pragma unroll
            for (int i = 0; i < 8; ++i) *(f32x4*)(go + 4 * i) = (f32x4){vals[4 * i], vals[4 * i + 1], vals[4 * i + 2], vals[4 * i + 3]};
        }
#pragma unroll
        for (int i = 0; i < 4; ++i) {
            v4u o; o.x = pk2(vals[8 * i], vals[8 * i + 1]); o.y = pk2(vals[8 * i + 2], vals[8 * i + 3]); o.z = pk2(vals[8 * i + 4], vals[8 * i + 5]); o.w = pk2(vals[8 * i + 6], vals[8 * i + 7]);
            *(LAS v4u*)(tile + s * VPITCH + part * 64 + 16 * i) = o;
        }
    }
    __syncthreads();
    if (16 * w < nvalid) {
        const int t = 16 * w + r;
        const int nu = samp ? 1 : (w >> 1) + 1;
        f32x4 o[8];
#pragma unroll
        for (int n = 0; n < 8; ++n) o[n] = (f32x4){0.f, 0.f, 0.f, 0.f};
        const int li = lane & 15, tq = li >> 2, tp = li & 3;
        LAS const unsigned char* trb = tile + (4 * g + tq) * VPITCH + tp * 8;
        const float* wrow = F.w_s + ((size_t)h * 128 + t) * 128;
        for (int u = 0; u < nu; ++u) {
            const int s0 = 32 * u + 4 * g, s1 = s0 + 16;
            f32x4 a0 = *(const f32x4*)(wrow + s0), a1 = *(const f32x4*)(wrow + s1);
#pragma unroll
            for (int e = 0; e < 4; ++e) { if (s0 + e > t) a0[e] = 0.f; if (s1 + e > t) a1[e] = 0.f; }
            const bf16x8 af = cvt8(a0, a1);
#pragma unroll
            for (int n = 0; n < 8; ++n) {
                const s16x4 lo = tr16(trb + (32 * u) * VPITCH + n * 32), hi = tr16(trb + (32 * u + 16) * VPITCH + n * 32);
                o[n] = __builtin_amdgcn_mfma_f32_16x16x32_bf16(af, cat8(lo, hi), o[n], 0, 0, 0);
            }
        }
#pragma unroll
        for (int e = 0; e < 4; ++e) {
            const int tt = 16 * w + 4 * g + e;
            if (tt < nvalid) {
                const float bias = F.b_s[h * 128 + tt];
                const bf16* up = F.U + (size_t)(row0 + tt) * 1024 + h * HD + r;
                bf16* op = F.MIXIN + (size_t)(row0 + tt) * 2048 + h * HD + r;
#pragma unroll
                for (int n = 0; n < 8; ++n) op[16 * n] = (bf16)f2bf(bf2f(up[16 * n]) * (o[n][e] + bias));
            }
        }
    }
    __syncthreads();
}

__device__ __forceinline__ void combine_prompt_row(const Frame& F, int m, float lam) {
    const int hh = F.lane >> 3, c = (F.lane & 7) * 16;
    const bf16* o1p = F.O4 + (size_t)m * 2048 + hh * 256 + c;
    const v4u a0 = *(const v4u*)o1p, a1 = *(const v4u*)(o1p + 8), b0 = *(const v4u*)(o1p + 128), b1 = *(const v4u*)(o1p + 136);
    float o[16];
    const unsigned aw[8] = {a0.x, a0.y, a0.z, a0.w, a1.x, a1.y, a1.z, a1.w}, bw[8] = {b0.x, b0.y, b0.z, b0.w, b1.x, b1.y, b1.z, b1.w};
    float ss = 0.f;
#pragma unroll
    for (int i = 0; i < 8; ++i) { o[2 * i] = bflo(aw[i]) - lam * bflo(bw[i]); o[2 * i + 1] = bfhi(aw[i]) - lam * bfhi(bw[i]); ss += o[2 * i] * o[2 * i] + o[2 * i + 1] * o[2 * i + 1]; }
    ss += __shfl_xor(ss, 1); ss += __shfl_xor(ss, 2); ss += __shfl_xor(ss, 4);
    const float rr = SUBLN_SCALE / sqrtf(ss * (1.0f / HD) + EPS);
    const float* gs = F.g_subln + c;
    v4u w0, w1;
    w0.x = pk2(o[0] * rr * gs[0], o[1] * rr * gs[1]); w0.y = pk2(o[2] * rr * gs[2], o[3] * rr * gs[3]); w0.z = pk2(o[4] * rr * gs[4], o[5] * rr * gs[5]); w0.w = pk2(o[6] * rr * gs[6], o[7] * rr * gs[7]);
    w1.x = pk2(o[8] * rr * gs[8], o[9] * rr * gs[9]); w1.y = pk2(o[10] * rr * gs[10], o[11] * rr * gs[11]); w1.z = pk2(o[12] * rr * gs[12], o[13] * rr * gs[13]); w1.w = pk2(o[14] * rr * gs[14], o[15] * rr * gs[15]);
    bf16* op = F.MIXIN + (size_t)m * 2048 + 1024 + hh * HD + c;
    *(v4u*)op = w0; *(v4u*)(op + 8) = w1;
}
__device__ __forceinline__ void combine_sample(const Frame& F, int task, float lam) {
    const int lane = F.lane, t = task & 7, h = (task >> 3) & 7, b = task >> 6;
    const int rowq = MPR + b * DSEQ + t;
    float om[2][2];
#pragma unroll
    for (int mp = 0; mp < 2; ++mp) {
        const int q = mp * 8 + t; const int sp = lane & 31;
        const size_t pb = ((size_t)(b * NH + h) * NSPLIT) * 16;
        const f32x2 ml = *(const f32x2*)(F.DML + ((pb + (size_t)sp * 16 + q) * 2));
        float sj = -INFINITY;
        if (lane <= t) {
            const bf16* qp = F.Q + (size_t)rowq * 1024 + h * HD + mp * 64; const bf16* kp = F.K + (size_t)(MPR + b * DSEQ + lane) * 1024 + h * HD + mp * 64;
            float s = 0.f;
            for (int d = 0; d < 64; ++d) s += bf2f(qp[d]) * bf2f(kp[d]);
            sj = s;
        }
        const float M = wave_max(fmaxf(ml.x, sj));
        const float wsp = (lane < 32) ? __builtin_amdgcn_exp2f(ml.x - M) : 0.f;
        const float pj = (lane <= t) ? __builtin_amdgcn_exp2f(sj - M) : 0.f;
        const float L = wave_sum(wsp * ml.y + pj);
        float a0 = 0.f, a1 = 0.f;
        for (int s = 0; s < NSPLIT; ++s) { const float ws = __shfl(wsp, s); const float* op = F.DPART + (pb + (size_t)s * 16 + q) * 128; a0 += ws * op[lane]; a1 += ws * op[lane + 64]; }
        for (int j = 0; j <= t; ++j) { const float p = __shfl(pj, j); const bf16* vp = F.V + (size_t)(MPR + b * DSEQ + j) * 1024 + h * HD; a0 += p * bf2f(vp[lane]); a1 += p * bf2f(vp[lane + 64]); }
        const float il = 1.0f / L;
        om[mp][0] = a0 * il; om[mp][1] = a1 * il;
    }
    const float o0 = om[0][0] - lam * om[1][0], o1 = om[0][1] - lam * om[1][1];
    const float ss = wave_sum(o0 * o0 + o1 * o1);
    const float rr = SUBLN_SCALE / sqrtf(ss * (1.0f / HD) + EPS);
    bf16* op = F.MIXIN + (size_t)rowq * 2048 + 1024 + h * HD;
    op[lane] = (bf16)f2bf(o0 * rr * F.g_subln[lane]); op[lane + 64] = (bf16)f2bf(o1 * rr * F.g_subln[lane + 64]);
}

__device__ __forceinline__ void postmix_row(const Frame& F, int m) {
    const float* xrow = m < MPR ? F.x_prompt + (size_t)m * DMODEL : F.x_sample + (size_t)(m - MPR) * DMODEL;
    const GAS f32x4* xr = (const GAS f32x4*)xrow + F.lane; const GAS f32x4* mr = (const GAS f32x4*)(F.MIX + (size_t)m * DMODEL) + F.lane;
    const GAS f32x4* g1 = (const GAS f32x4*)F.g_post_mix + F.lane; const GAS f32x4* g2 = (const GAS f32x4*)F.g_pre_ffn + F.lane;
    f32x4 v[8]; float s = 0.f;
#pragma unroll
    for (int j = 0; j < 8; ++j) {
        if (m < MPR) v[j] = mr[64 * j];
        else { const GAS f32x4* pr = (const GAS f32x4*)(F.PARTM + (size_t)(m - MPR) * DMODEL) + F.lane + 64 * j; f32x4 a = pr[0];
            for (int ks = 1; ks < KS_MIX; ++ks) a += pr[(size_t)ks * 64 * DMODEL / 4]; v[j] = a; }
        s += (v[j].x * v[j].x + v[j].y * v[j].y) + (v[j].z * v[j].z + v[j].w * v[j].w); }
    const float r1 = 1.0f / sqrtf(wave_sum(s) * (1.f / DMODEL) + EPS);
    GAS f32x4* hr = (GAS f32x4*)(F.H + (size_t)m * DMODEL) + F.lane;
    float s2 = 0.f;
#pragma unroll
    for (int j = 0; j < 8; ++j) { v[j] = xr[64 * j] + v[j] * r1 * g1[64 * j]; hr[64 * j] = v[j]; s2 += (v[j].x * v[j].x + v[j].y * v[j].y) + (v[j].z * v[j].z + v[j].w * v[j].w); }
    const float r2 = 1.0f / sqrtf(wave_sum(s2) * (1.f / DMODEL) + EPS);
    GAS unsigned long long* o8 = (GAS unsigned long long*)(F.HN + (size_t)m * DMODEL) + F.lane;
#pragma unroll
    for (int j = 0; j < 8; ++j) { const f32x4 y = v[j] * r2 * g2[64 * j]; o8[64 * j] = (unsigned long long)pk2(y.x, y.y) | ((unsigned long long)pk2(y.z, y.w) << 32); }
}
__device__ __forceinline__ void final_row(const Frame& F, int m) {
    const GAS f32x4* yr = (const GAS f32x4*)(F.Y + (size_t)m * DMODEL) + F.lane; const GAS f32x4* hr = (const GAS f32x4*)(F.H + (size_t)m * DMODEL) + F.lane;
    const GAS f32x4* g1 = (const GAS f32x4*)F.g_post_ffn + F.lane;
    float* orow = m < MPR ? F.out + OUT_YP + (size_t)m * DMODEL : F.out + OUT_YS + (size_t)(m - MPR) * DMODEL;
    GAS f32x4* o4 = (GAS f32x4*)orow + F.lane;
    f32x4 v[8]; float s = 0.f;
#pragma unroll
    for (int j = 0; j < 8; ++j) {
        if (m < MPR) v[j] = yr[64 * j];
        else { const GAS f32x4* pr = (const GAS f32x4*)(F.PARTY + (size_t)(m - MPR) * DMODEL) + F.lane + 64 * j; f32x4 a = pr[0];
            for (int ks = 1; ks < KS_Y; ++ks) a += pr[(size_t)ks * 64 * DMODEL / 4]; v[j] = a; }
        s += (v[j].x * v[j].x + v[j].y * v[j].y) + (v[j].z * v[j].z + v[j].w * v[j].w); }
    const float r1 = 1.0f / sqrtf(wave_sum(s) * (1.f / DMODEL) + EPS);
#pragma unroll
    for (int j = 0; j < 8; ++j) o4[64 * j] = hr[64 * j] + v[j] * r1 * g1[64 * j];
}
__device__ __forceinline__ void ld8bf(const bf16* p, float (&o)[8]) { const v4u w = *(const v4u*)p; o[0] = bflo(w.x); o[1] = bfhi(w.x); o[2] = bflo(w.y); o[3] = bfhi(w.y); o[4] = bflo(w.z); o[5] = bfhi(w.z); o[6] = bflo(w.w); o[7] = bfhi(w.w); }
__device__ __forceinline__ void ld8f(const float* p, float (&o)[8]) { const f32x4 a = *(const f32x4*)p, b = *(const f32x4*)(p + 4); o[0] = a[0]; o[1] = a[1]; o[2] = a[2]; o[3] = a[3]; o[4] = b[0]; o[5] = b[1]; o[6] = b[2]; o[7] = b[3]; }
__device__ __forceinline__ void conv_tap(const Frame& F, int m, int k, int col, float (&o)[8]) {
    const bool samp = m >= MPR; const int t = samp ? ((m - MPR) & 7) : (m & (SEQ - 1));
    if (t - k >= 0) ld8bf(F.UP + (size_t)(m - k) * DUP + col, o);
    else if (samp) ld8f(F.state_conv + (size_t)(((m - MPR) >> 3) * 2 + (2 + t - k)) * DUP + col, o);
    else {
#pragma unroll
        for (int i = 0; i < 8; ++i) o[i] = 0.f;
    }
}
__device__ __forceinline__ void conv_task(const Frame& F, int task) {
    constexpr int NCC = DFF / 512;
    const int rb = task / NCC, cc = task % NCC, m0 = rb * 16, gc = cc * 512 + 8 * F.lane, vc = DFF + gc;
    float wg[3][8], wv[3][8], bg[8], bv[8];
#pragma unroll
    for (int j = 0; j < 3; ++j) { ld8f(F.w_conv + (size_t)j * DUP + gc, wg[j]); ld8f(F.w_conv + (size_t)j * DUP + vc, wv[j]); }
    ld8f(F.b_conv + gc, bg); ld8f(F.b_conv + vc, bv);
    float g1[8], g2[8], v1[8], v2[8], cg[8], cv[8];
    conv_tap(F, m0, 1, gc, g1); conv_tap(F, m0, 2, gc, g2); conv_tap(F, m0, 1, vc, v1); conv_tap(F, m0, 2, vc, v2);
    for (int i = 0; i < 16; ++i) {
        const int m = m0 + i;
        if (i > 0 && m >= MPR && ((m - MPR) & 7) == 0) { conv_tap(F, m, 1, gc, g1); conv_tap(F, m, 2, gc, g2); conv_tap(F, m, 1, vc, v1); conv_tap(F, m, 2, vc, v2); }
        ld8bf(F.UP + (size_t)m * DUP + gc, cg); ld8bf(F.UP + (size_t)m * DUP + vc, cv);
        float og[8];
#pragma unroll
        for (int e = 0; e < 8; ++e) {
            const float a = bg[e] + wg[0][e] * g2[e] + wg[1][e] * g1[e] + wg[2][e] * cg[e];
            const float c = bv[e] + wv[0][e] * v2[e] + wv[1][e] * v1[e] + wv[2][e] * cv[e];
            og[e] = gelu_f(a) * c;
            g2[e] = g1[e]; g1[e] = cg[e]; v2[e] = v1[e]; v1[e] = cv[e];
        }
        v4u w; w.x = pk2(og[0], og[1]); w.y = pk2(og[2], og[3]); w.z = pk2(og[4], og[5]); w.w = pk2(og[6], og[7]);
        *(v4u*)(F.GB + (size_t)m * DFF + gc) = w;
    }
}

struct Args { const void* in[24]; float* out; unsigned char* ws; int ph_lo, ph_hi, sub_mask, pad; };
__global__ void __launch_bounds__(NWAVES * 64, 2) fwd_kernel(Args args) {
    extern __shared__ __attribute__((aligned(16))) unsigned char lds[];
    Frame F;
    F.lds = (LAS unsigned char*)lds;
    F.MISC = (volatile LAS unsigned*)(F.lds + MISC_OFF);
    F.tid = threadIdx.x; F.lane = F.tid & 63; F.wave = __builtin_amdgcn_readfirstlane(F.tid >> 6);
    F.G = gridDim.x; { const int bx = blockIdx.x; F.vcu = (F.G % 8 == 0) ? (bx % 8) * (F.G / 8) + bx / 8 : bx; }
    unsigned char* ws = args.ws;
    F.ctl = (gu32*)(ws + WS_CTL);
    F.x_prompt = (const float*)args.in[0]; F.x_sample = (const float*)args.in[1]; F.cache_k = (const float*)args.in[2]; F.cache_v = (const float*)args.in[3];
    F.state_conv = (const float*)args.in[4]; F.page_table = (const int*)args.in[5]; F.g_pre_mix = (const float*)args.in[6]; F.w_in = (const float*)args.in[7];
    F.g_v_a = (const float*)args.in[8]; F.w_s = (const float*)args.in[9]; F.b_s = (const float*)args.in[10]; F.lq1 = (const float*)args.in[11]; F.lk1 = (const float*)args.in[12];
    F.lq2 = (const float*)args.in[13]; F.lk2 = (const float*)args.in[14]; F.g_subln = (const float*)args.in[15]; F.w_out = (const float*)args.in[16]; F.g_post_mix = (const float*)args.in[17];
    F.g_pre_ffn = (const float*)args.in[18]; F.w_up = (const float*)args.in[19]; F.w_conv = (const float*)args.in[20]; F.b_conv = (const float*)args.in[21]; F.w_down = (const float*)args.in[22];
    F.g_post_ffn = (const float*)args.in[23]; F.out = args.out;
    F.Win_t = (bf16*)(ws + WS_WIN); F.Wout_t = (bf16*)(ws + WS_WOUT); F.Wup_t = (bf16*)(ws + WS_WUP); F.Wdn_t = (bf16*)(ws + WS_WDN);
    F.XN = (bf16*)(ws + WS_XN); F.U = (bf16*)(ws + WS_U); F.VA = (bf16*)(ws + WS_VA); F.Q = (bf16*)(ws + WS_Q); F.K = (bf16*)(ws + WS_K); F.V = (bf16*)(ws + WS_V);
    F.O4 = (bf16*)(ws + WS_O4); F.MIXIN = (bf16*)(ws + WS_MIXIN); F.HN = (bf16*)(ws + WS_HN); F.UP = (bf16*)(ws + WS_UP); F.GB = (bf16*)(ws + WS_G);
    F.MIX = (float*)(ws + WS_MIX); F.H = (float*)(ws + WS_H); F.Y = (float*)(ws + WS_Y); F.DPART = (float*)(ws + WS_DPART); F.DML = (float*)(ws + WS_DML); F.PARTM = (float*)(ws + WS_PARTM); F.PARTY = (float*)(ws + WS_PARTY);
    for (int u = F.tid; u < (LDS_BYTES - LDSCTL_OFF) / 4; u += NWAVES * 64) ((LAS unsigned*)(F.lds + LDSCTL_OFF))[u] = 0u;
    __syncthreads();
    XcdBarrier bar; bar.bar = (unsigned*)(F.ctl + CW_BAR); bar.x = 0; bar.st = nullptr;
    if (N_LAUNCHES == 1) bar = xcd_barrier_post((unsigned*)(F.ctl + CW_BAR), F.MISC + 8);
#define GRID_BAR() do { if (N_LAUNCHES == 1) xcd_barrier(bar); } while (0)
    const int lo = args.ph_lo, hi = args.ph_hi;
#define IN(k) (lo <= (k) && (k) < hi)
#define BOTH(k) (IN(k) && IN((k) + 1))
    const int gw = F.vcu * NWAVES + F.wave, NGW = F.G * NWAVES;
#if 0
#define STAMP(i) do { if (F.tid == 0) F.MISC[32 + (i)] = (unsigned)rt(); } while (0)
#else
#define STAMP(i) do { } while (0)
#endif

    STAMP(0);
    if (IN(0)) { p0_prologue(F); if (BOTH(0)) GRID_BAR(); }

    STAMP(1);
    if (IN(1)) {
        pg8::Gemm g{F.XN, F.Win_t, MPAD, DIN, DMODEL, DMODEL}; pg8::StaticOrder S; S.init(MPAD, DIN, F.G, (int)blockIdx.x);
        pg8::EpiIn E{F.U, F.VA, F.Q, F.K, F.V, F.out + OUT_KP, F.out + OUT_VP, F.out + OUT_KS, F.out + OUT_VS, C2};
        pg8::gemm_phase<pg8::EpiIn, pg8::StaticOrder, PG8_ALIGN, PG8_SP2>(F.lds + RING_OFF, g, S, E);
        if (BOTH(1)) GRID_BAR();
    }

    STAMP(2);
    if (IN(2)) {
        const attn_body::AttnTensors AT{(const attn_body::bf16*)F.Q, (const attn_body::bf16*)F.K, (const attn_body::bf16*)F.V, (attn_body::bf16*)F.O4};
        constexpr int NQ_TOTAL = 1280 + 512 + DBATCH * NH;
        for (;;) {
            __syncthreads();
            if (F.tid == 0) F.MISC[20] = __hip_atomic_fetch_add(F.ctl + CW_Q2, 1u, __ATOMIC_RELAXED, __HIP_MEMORY_SCOPE_AGENT);
            __syncthreads();
            const int idx = (int)F.MISC[20];
            if (idx >= NQ_TOTAL) break;
            if (idx < 1024 && (idx & 3) == 3) { const int du = idx >> 2; if (args.sub_mask & 1) decode_unit(F, du / NSPLIT, du % NSPLIT); }
            else if (idx < 1280) {
                const int a = idx < 1024 ? (idx >> 2) * 3 + (idx & 3) : 768 + (idx - 1024);
                const int qb = 15 - (a >> 6), combo = a & 63, vh = combo & 1, mp = (combo >> 1) & 1, h = (combo >> 2) & 7, b = combo >> 5;
                if (args.sub_mask & 2) attn_body::attn_unit<8>(b, 2 * h + mp, 2 * h + vh, h * 256 + mp * 128 + vh * 64, qb, AT.Q, AT.K, AT.V, AT.O, (char*)lds + RING_OFF);
            } else { if (args.sub_mask & 4) gmlp_unit(F, idx - 1280); }
        }
        if (BOTH(2)) GRID_BAR();
    }

    STAMP(3);
    if (IN(3)) {
        const float lam = lam_of(F);
        for (int task = gw; task < DBATCH * NH * DSEQ; task += NGW) combine_sample(F, task, lam);
        for (int m = gw; m < MPR; m += NGW) combine_prompt_row(F, m, lam);
        if (BOTH(3)) GRID_BAR();
    }

    STAMP(4);
    if (IN(4)) {
        pg8::Gemm g{F.MIXIN, F.Wout_t, MPR, DMODEL, DMODEL, DMODEL}; pg8::StaticOrder S; S.init(MPR, DMODEL, F.G, (int)blockIdx.x);
        pg8::EpiF32 E{F.MIX, DMODEL};
        pg8::gemm_phase<pg8::EpiF32, pg8::StaticOrder, PG8_ALIGN, PG8_SP2>(F.lds + RING_OFF, g, S, E);
        pg8::Gemm gs{F.MIXIN, F.Wout_t, MPAD, DMODEL, KL_MIX, DMODEL}; const pg8::SplitKOrder SS{F.vcu, 8 * KS_MIX, 8, KL_MIX, MPR / 256};
        pg8::EpiPart EP{F.PARTM, KL_MIX};
        pg8::gemm_phase<pg8::EpiPart, pg8::SplitKOrder, false, PG8_SP2>(F.lds + RING_OFF, gs, SS, EP);
        if (BOTH(4)) GRID_BAR();
    }

    STAMP(5);
    if (IN(5)) { for (int m = gw; m < MREAL; m += NGW) postmix_row(F, m); if (BOTH(5)) GRID_BAR(); }

    STAMP(6);
    if (IN(6)) {
        pg8::Gemm g{F.HN, F.Wup_t, MPAD, DUP, DMODEL, DMODEL}; pg8::StaticOrder S; S.init(MPAD, DUP, F.G, (int)blockIdx.x);
        pg8::EpiUp E{F.UP, F.out + OUT_CP, F.out + OUT_CS};
        pg8::gemm_phase<pg8::EpiUp, pg8::StaticOrder, PG8_ALIGN, PG8_SP2>(F.lds + RING_OFF, g, S, E);
        if (BOTH(6)) GRID_BAR();
    }

    STAMP(7);
    if (IN(7)) { for (int task = gw; task < (MREAL / 16) * (DFF / 512); task += NGW) conv_task(F, task); if (BOTH(7)) GRID_BAR(); }

    STAMP(8);
    if (IN(8)) {
        pg8::Gemm g{F.GB, F.Wdn_t, MPR, DMODEL, DFF, DFF}; pg8::StaticOrder S; S.init(MPR, DMODEL, F.G, (int)blockIdx.x);
        pg8::EpiF32 E{F.Y, DMODEL};
        pg8::gemm_phase<pg8::EpiF32, pg8::StaticOrder, PG8_ALIGN, PG8_SP2>(F.lds + RING_OFF, g, S, E);
        pg8::Gemm gs{F.GB, F.Wdn_t, MPAD, DMODEL, KL_Y, DFF}; const pg8::SplitKOrder SS{F.vcu, 8 * KS_Y, 8, KL_Y, MPR / 256};
        pg8::EpiPart EP{F.PARTY, KL_Y};
        pg8::gemm_phase<pg8::EpiPart, pg8::SplitKOrder, false, PG8_SP2>(F.lds + RING_OFF, gs, SS, EP);
        if (BOTH(8)) GRID_BAR();
    }

    STAMP(9);
    if (IN(9)) { for (int m = gw; m < MREAL; m += NGW) final_row(F, m); }

#undef IN
#undef BOTH
}

extern "C" void kernel_launch(void* const* d_in, const int* in_sizes, int n_in, void* d_out, int out_size, void* d_ws, size_t ws_size, hipStream_t stream) {
    static int grid = 0;
    if (grid == 0) {
        if (n_in != 24 || (size_t)out_size != OUT_END || ws_size < WS_END) { fprintf(stderr, "kernel_launch: unexpected shapes: n_in %d out %d ws %zu (need %zu)\n", n_in, out_size, ws_size, (size_t)WS_END); grid = -1; return; }
        int dev = 0, cus = 0, per_cu = 0;
        if (hipGetDevice(&dev) != hipSuccess || hipDeviceGetAttribute(&cus, hipDeviceAttributeMultiprocessorCount, dev) != hipSuccess) { grid = -1; return; }
        if (hipFuncSetAttribute((const void*)fwd_kernel, hipFuncAttributeMaxDynamicSharedMemorySize, LDS_BYTES) != hipSuccess) { fprintf(stderr, "kernel_launch: hipFuncSetAttribute failed\n"); grid = -1; return; }
        if (hipOccupancyMaxActiveBlocksPerMultiprocessor(&per_cu, (const void*)fwd_kernel, NWAVES * 64, LDS_BYTES) != hipSuccess || per_cu < 1) { fprintf(stderr, "kernel_launch: occupancy query says %d blocks per CU\n", per_cu); }
        (void)hipGetLastError();
        grid = cus;
    }
    if (grid < 0) return;
    if (hipMemsetAsync((char*)d_ws + WS_CTL, 0, CTL_ZERO_BYTES, stream) != hipSuccess) return;
    Args a{};
    for (int i = 0; i < 24; ++i) a.in[i] = d_in[i];
    a.out = (float*)d_out; a.ws = (unsigned char*)d_ws; a.sub_mask = 7;
    for (int li = 0; li < N_LAUNCHES; ++li) {
        a.ph_lo = (N_LAUNCHES == 1) ? 0 : li; a.ph_hi = (N_LAUNCHES == 1) ? N_PHASES : li + 1;
        hipLaunchKernelGGL(fwd_kernel, dim3(grid), dim3(NWAVES * 64), LDS_BYTES, stream, a);
        const hipError_t le = hipPeekAtLastError();
        if (le != hipSuccess) { fprintf(stderr, "kernel_launch: launch %d failed: %s\n", li, hipGetErrorName(le)); break; }
    }
#if defined(EXTRA_PHASE)
    for (int e = 0; e < EXTRA_N; ++e) { a.ph_lo = EXTRA_PHASE; a.ph_hi = EXTRA_PHASE + 1; a.sub_mask = EXTRA_SUB; hipLaunchKernelGGL(fwd_kernel, dim3(grid), dim3(NWAVES * 64), LDS_BYTES, stream, a); }
#endif
}
```
